# Optimizing an MI355X kernel written in HIP

```python
import jax, jax.numpy as jnp
from jax import lax
import numpy as np

D_MODEL = 1024
BATCH = 2
SEQ = 16384
DEPTH = 2
DEC_BATCH = 8
DEC_SEQ = 4096
PAST_LEN = 128

CHUNK = 128
A_HEADS = 8
A_HEAD_DIM = D_MODEL // A_HEADS
A_WIDTH = A_HEADS * A_HEAD_DIM
B_GROUPS = 4
B_WIDTH = D_MODEL
B_GROUP_DIM = B_WIDTH // B_GROUPS
N_BRANCH = 2
D_FF = ((8 * D_MODEL // 3 + 255) // 256) * 256
IN_WIDTH = 2 * A_WIDTH + B_WIDTH + N_BRANCH * D_MODEL
EPS = 1e-6

kernel_name = "hybrid_gmlp_fnet_macaron_encoder"


def rms_norm(x, g):
    x32 = x.astype(jnp.float32)
    y = x32 * lax.rsqrt(jnp.mean(x32 * x32, axis=-1, keepdims=True) + EPS)
    return (y * g.astype(jnp.float32)).astype(x.dtype)


def swiglu_ffn(h, w_gate, w_up, w_down):
    return (jax.nn.silu(h @ w_gate) * (h @ w_up)) @ w_down


def spatial_gating(u, v, g_v, w_s, b_s):
    bsz, s, _ = u.shape
    v = rms_norm(v, g_v).reshape(bsz, s // CHUNK, CHUNK, A_HEADS, A_HEAD_DIM)
    v = jnp.einsum('hpq,bcqhd->bcphd', w_s, v) + b_s.T[None, None, :, :, None]
    return u * v.reshape(bsz, s, A_WIDTH)


def fourier_mix(z):
    bsz, s, _ = z.shape
    zg = z.astype(jnp.float32).reshape(bsz, s, B_GROUPS, B_GROUP_DIM)
    f = jnp.fft.fft2(zg, axes=(1, 3), norm="ortho").real
    return f.reshape(bsz, s, B_WIDTH).astype(z.dtype)


def hybrid_mixer(h, w_in, g_v, w_s, b_s, w_branch_a, w_branch_b, w_out):
    z = h @ w_in
    splits = [A_WIDTH, 2 * A_WIDTH, 2 * A_WIDTH + B_WIDTH, 2 * A_WIDTH + B_WIDTH + D_MODEL]
    u, v, z_b, g_a, g_b = jnp.split(z, splits, axis=-1)
    y_a = spatial_gating(jax.nn.gelu(u, approximate=False), jax.nn.gelu(v, approximate=False),
                         g_v, w_s, b_s) @ w_branch_a
    y_b = fourier_mix(z_b) @ w_branch_b
    merged = jax.nn.sigmoid(g_a) * y_a + jax.nn.sigmoid(g_b) * y_b
    return merged @ w_out


def setup_inputs(seed: int = 0) -> dict:
    key = jax.random.key(seed)
    ks = jax.random.split(key, 24)

    def nrm(k, shape, scale):
        return jax.random.normal(k, shape, jnp.float32) * scale

    def gain(k, shape):
        return 1.0 + nrm(k, shape, 0.02)

    return {
        "x_prompt": nrm(ks[0], (BATCH, SEQ, D_MODEL), 1.0),
        "x_sample": nrm(ks[1], (DEC_BATCH, DEC_SEQ, D_MODEL), 1.0),
        "ffn1_norm": gain(ks[2], (DEPTH, D_MODEL)),
        "ffn1_w_gate": nrm(ks[3], (DEPTH, D_MODEL, D_FF), D_MODEL ** -0.5),
        "ffn1_w_up": nrm(ks[4], (DEPTH, D_MODEL, D_FF), D_MODEL ** -0.5),
        "ffn1_w_down": nrm(ks[5], (DEPTH, D_FF, D_MODEL), D_FF ** -0.5),
        "mix_norm": gain(ks[6], (DEPTH, D_MODEL)),
        "w_in": nrm(ks[7], (DEPTH, D_MODEL, IN_WIDTH), D_MODEL ** -0.5),
        "sgu_norm": gain(ks[8], (DEPTH, A_WIDTH)),
        "sgu_w": nrm(ks[9], (DEPTH, A_HEADS, CHUNK, CHUNK), CHUNK ** -0.5),
        "sgu_b": 1.0 + nrm(ks[10], (DEPTH, A_HEADS, CHUNK), 0.1),
        "w_branch_a": nrm(ks[11], (DEPTH, A_WIDTH, D_MODEL), A_WIDTH ** -0.5),
        "w_branch_b": nrm(ks[12], (DEPTH, B_WIDTH, D_MODEL), B_WIDTH ** -0.5),
        "w_out": nrm(ks[13], (DEPTH, D_MODEL, D_MODEL), D_MODEL ** -0.5),
        "ffn2_norm": gain(ks[14], (DEPTH, D_MODEL)),
        "ffn2_w_gate": nrm(ks[15], (DEPTH, D_MODEL, D_FF), D_MODEL ** -0.5),
        "ffn2_w_up": nrm(ks[16], (DEPTH, D_MODEL, D_FF), D_MODEL ** -0.5),
        "ffn2_w_down": nrm(ks[17], (DEPTH, D_FF, D_MODEL), D_FF ** -0.5),
        "final_norm": gain(ks[18], (D_MODEL,)),
    }


def reference(x_prompt, x_sample, ffn1_norm, ffn1_w_gate, ffn1_w_up, ffn1_w_down,
              mix_norm, w_in, sgu_norm, sgu_w, sgu_b, w_branch_a, w_branch_b, w_out,
              ffn2_norm, ffn2_w_gate, ffn2_w_up, ffn2_w_down, final_norm):
    def trunk(x):
        for l in range(DEPTH):
            x = x + 0.5 * swiglu_ffn(rms_norm(x, ffn1_norm[l]),
                                     ffn1_w_gate[l], ffn1_w_up[l], ffn1_w_down[l])
            x = x + hybrid_mixer(rms_norm(x, mix_norm[l]), w_in[l], sgu_norm[l],
                                 sgu_w[l], sgu_b[l], w_branch_a[l], w_branch_b[l], w_out[l])
            x = x + 0.5 * swiglu_ffn(rms_norm(x, ffn2_norm[l]),
                                     ffn2_w_gate[l], ffn2_w_up[l], ffn2_w_down[l])
        return rms_norm(x, final_norm)

    y_prompt = trunk(x_prompt)
    y_sample = trunk(x_sample)
    return (y_prompt, y_sample)
```

```cpp
#include <hip/hip_runtime.h>
#include <hip/hip_cooperative_groups.h>
#include <cstdio>
#include <cstdint>
namespace cg = cooperative_groups;
namespace pg8 {
#define PG8_LAS __attribute__((address_space(3)))
typedef unsigned short bf16_t;
typedef short bf16x8 __attribute__((ext_vector_type(8)));
typedef float f32x4 __attribute__((ext_vector_type(4)));
typedef unsigned u32x4 __attribute__((ext_vector_type(4)));
constexpr int BM = 256, BK = 64, HALF = 128, HTB = HALF * BK * 2  , STAGE_BYTES = 8 * HTB, NXCD = 8, WGM = 8;

__host__ __device__ __forceinline__ int lds_byte(int r, int c) { const int st = (r >> 4) * 2 + (c >> 5), rr = r & 15, cc = c & 31, ob = rr * 64 + cc * 2; return st * 1024 + (ob ^ (((ob >> 9) & 1) << 5)); }
__host__ __device__ __forceinline__ void stage_rc(int b, int& R, int& C) { const int st = b / 1024, sb = b % 1024, swz = sb ^ (((sb >> 9) & 1) << 5); R = (st >> 1) * 16 + swz / 64; C = (st & 1) * 32 + (swz % 64) / 2; }
__host__ __device__ __forceinline__ int perm32(int rho) { const int n = rho >> 4, i = rho & 15; return 8 * (i >> 2) + 4 * n + (i & 3); }

struct Unit { int pm, pn; };
struct Gemm { const bf16_t* A; const bf16_t* Bt; int M, N, K; };

struct StaticOrder {
    int nM, nN, nwg, G, c;
    __host__ __device__ void init(int M, int N, int G_, int c_) { nM = M / BM; nN = N / BM; nwg = nM * nN; G = G_; c = c_; }
    __host__ __device__ bool next(int i, Unit& u) const {
        const long L = (long)i * G + c; if (L >= nwg) return false;
        int wgid = (int)L; { const int q = nwg / NXCD, r = nwg % NXCD, xcd = wgid % NXCD, off = wgid / NXCD; wgid = (xcd < r ? xcd * (q + 1) : r * (q + 1) + (xcd - r) * q) + off; }
        const int nig = WGM * nN, gid = wgid / nig, fm = gid * WGM, gsz = (nM - fm) < WGM ? (nM - fm) : WGM;
        u.pm = fm + ((wgid % nig) % gsz); u.pn = (wgid % nig) / gsz; return true;
    }
    __device__ __forceinline__ void a_ready(const Unit&) const {}
    __device__ __forceinline__ void done(const Unit&) const {}
};

typedef __bf16 bf16x2_t __attribute__((ext_vector_type(2)));
__device__ __forceinline__ unsigned cvt_pk_bf16(float lo, float hi) { typedef float f32x2_ __attribute__((ext_vector_type(2))); const bf16x2_t r = __builtin_convertvector((f32x2_){lo, hi}, bf16x2_t); return __builtin_bit_cast(unsigned, r); }
typedef float f32x2 __attribute__((ext_vector_type(2)));
__device__ __forceinline__ f32x2 gelu_pk(f32x2 v) {
    const f32x2 av = __builtin_elementwise_abs(v), d = av * 0.2316418882f + 1.0f;
    f32x2 t; t.x = __builtin_amdgcn_rcpf(d.x); t.y = __builtin_amdgcn_rcpf(d.y);
    f32x2 q = t * 0.5307027145f + (-0.7265760135f); q = q * t + 0.7107068705f; q = q * t + (-0.142248368f); q = q * t + 0.127414796f; q = q * t;
    const f32x2 s = (v * v) * (-0.72134752044f);
    f32x2 e; e.x = __builtin_amdgcn_exp2f(s.x); e.y = __builtin_amdgcn_exp2f(s.y);
    const f32x2 m = v * (q * e), r = v - m;
    f32x2 o; o.x = v.x < 0.f ? m.x : r.x; o.y = v.y < 0.f ? m.y : r.y; return o;
}

typedef unsigned u32x2 __attribute__((ext_vector_type(2)));
__device__ __forceinline__ float bf_lo(unsigned w) { return __builtin_bit_cast(float, w << 16); }
__device__ __forceinline__ float bf_hi(unsigned w) { return __builtin_bit_cast(float, w & 0xffff0000u); }
__device__ __forceinline__ float row_rscale(const float* ssp, int row, int fq) {
    const f32x4 v = *(const f32x4*)(ssp + (size_t)row * 16 + fq * 4);
    float s = (v[0] + v[1]) + (v[2] + v[3]);
    s += __shfl_xor(s, 16); s += __shfl_xor(s, 32);
    return __builtin_amdgcn_rsqf(s * (1.0f / 1024.0f) + 1e-6f);
}
__device__ __forceinline__ float sigmoid_f(float x) { return __builtin_amdgcn_rcpf(1.0f + __builtin_amdgcn_exp2f(x * -1.44269504089f)); }

__device__ __forceinline__ void row_rscales(const float* ssp, int row0, int fq, float (&r)[2][4], float (&ms)[2][4]) {
    f32x4 sv[2][4];
#pragma unroll
    for (int ai = 0; ai < 2; ++ai)
#pragma unroll
        for (int m = 0; m < 4; ++m) sv[ai][m] = *(const f32x4*)(ssp + (size_t)(row0 + ai * HALF + m * 16) * 16 + fq * 4);
#pragma unroll
    for (int ai = 0; ai < 2; ++ai)
#pragma unroll
        for (int m = 0; m < 4; ++m) { const f32x4 v = sv[ai][m]; float s = (v[0] + v[1]) + (v[2] + v[3]); s += __shfl_xor(s, 16); s += __shfl_xor(s, 32);
            ms[ai][m] = s * (1.0f / 1024.0f) + 1e-6f; r[ai][m] = __builtin_amdgcn_rsqf(ms[ai][m]); }
}
__device__ __forceinline__ void row_rscales(const float* ssp, int row0, int fq, float (&r)[2][4]) { float ms[2][4]; row_rscales(ssp, row0, fq, r, ms); }
struct EpiSwiGLU {
    static constexpr bool PERM = true, AFTER_DRAIN = false;
    bf16_t* H; const float* ssp; int ldh;
    __device__ __forceinline__ void operator()(const f32x4 (&acc)[2][2][4][2], const Unit& u, int wr, int wc, int fr, int fq) const {
        const int row0 = u.pm * BM + wr * 64 + fr, col0 = u.pn * HALF + wc * 32 + 8 * fq;
        float rs[2][4], msq[2][4]; row_rscales(ssp, row0, fq, rs, msq);
#pragma unroll
        for (int ai = 0; ai < 2; ++ai)
#pragma unroll
            for (int m = 0; m < 4; ++m) { const int row = row0 + ai * HALF + m * 16; const float r = rs[ai][m], mq = msq[ai][m];
                unsigned w[4];
                const float rc = r * -1.44269504089f;
#pragma unroll
                for (int n = 0; n < 2; ++n) { const f32x4 ga = acc[ai][0][m][n], gu = ga * acc[ai][1][m][n], ex = ga * rc; float h[4];
#pragma unroll
                    for (int j = 0; j < 4; ++j) h[j] = gu[j] * __builtin_amdgcn_rcpf(__builtin_fmaf(__builtin_amdgcn_exp2f(ex[j]), mq, mq));
                    w[2 * n] = cvt_pk_bf16(h[0], h[1]); w[2 * n + 1] = cvt_pk_bf16(h[2], h[3]); }
                u32x4 o; o.x = w[0]; o.y = w[1]; o.z = w[2]; o.w = w[3];
                *(u32x4*)(H + (size_t)row * ldh + col0) = o; }
    }
};
struct EpiResid {
    static constexpr bool PERM = true, AFTER_DRAIN = false;
    bf16_t* xb; float* ssp; float scale;
    __device__ __forceinline__ void operator()(const f32x4 (&acc)[2][2][4][2], const Unit& u, int wr, int wc, int fr, int fq) const {
        const int row0 = u.pm * BM + wr * 64 + fr, col0 = u.pn * BM + wc * 32 + 8 * fq;
#pragma unroll
        for (int ai = 0; ai < 2; ++ai) {
            u32x4 a[4][2];
#pragma unroll
            for (int m = 0; m < 4; ++m)
#pragma unroll
                for (int bj = 0; bj < 2; ++bj) a[m][bj] = *(const u32x4*)(xb + (size_t)(row0 + ai * HALF + m * 16) * 1024 + col0 + bj * HALF);
#pragma unroll
            for (int m = 0; m < 4; ++m) { const int row = row0 + ai * HALF + m * 16; float ss = 0.f;
#pragma unroll
                for (int bj = 0; bj < 2; ++bj) { const f32x4 v0 = acc[ai][bj][m][0] * scale, v1 = acc[ai][bj][m][1] * scale; const u32x4 x = a[m][bj];
                    const f32x4 o0 = (f32x4){bf_lo(x.x) + v0[0], bf_hi(x.x) + v0[1], bf_lo(x.y) + v0[2], bf_hi(x.y) + v0[3]};
                    const f32x4 o1 = (f32x4){bf_lo(x.z) + v1[0], bf_hi(x.z) + v1[1], bf_lo(x.w) + v1[2], bf_hi(x.w) + v1[3]};
                    ss += (o0[0] * o0[0] + o0[1] * o0[1]) + (o0[2] * o0[2] + o0[3] * o0[3]) + (o1[0] * o1[0] + o1[1] * o1[1]) + (o1[2] * o1[2] + o1[3] * o1[3]);
                    u32x4 w; w.x = cvt_pk_bf16(o0[0], o0[1]); w.y = cvt_pk_bf16(o0[2], o0[3]); w.z = cvt_pk_bf16(o1[0], o1[1]); w.w = cvt_pk_bf16(o1[2], o1[3]);
                    *(u32x4*)(xb + (size_t)row * 1024 + col0 + bj * HALF) = w; }
                ss += __shfl_xor(ss, 16); ss += __shfl_xor(ss, 32);
                if (fq == 0) ssp[(size_t)row * 16 + u.pn * 4 + wc] = ss; }
            asm volatile("" ::: "memory"); }
    }
};
struct EpiW1 {
    static constexpr bool PERM = true, AFTER_DRAIN = false;
    bf16_t* dst0; bf16_t* dst1; size_t gstride; const float* ssp; float* ssv;
    __device__ __forceinline__ void operator()(const f32x4 (&acc)[2][2][4][2], const Unit& u, int wr, int wc, int fr, int fq) const {
        const int grp = u.pn >> 2, row0 = u.pm * BM + wr * 64 + fr, col0 = (u.pn & 3) * BM + wc * 32 + 8 * fq;
        bf16_t* dst = grp < 4 ? dst0 + (size_t)grp * gstride : dst1 + (size_t)(grp - 4) * gstride;
        float rs[2][4]; row_rscales(ssp, row0, fq, rs);
#pragma unroll
        for (int ai = 0; ai < 2; ++ai)
#pragma unroll
            for (int m = 0; m < 4; ++m) { const int row = row0 + ai * HALF + m * 16; const float r = rs[ai][m]; float ss = 0.f;
#pragma unroll
                for (int bj = 0; bj < 2; ++bj) { f32x4 v0 = acc[ai][bj][m][0] * r, v1 = acc[ai][bj][m][1] * r;
                    if (grp < 2) { const f32x2 a = gelu_pk((f32x2){v0[0], v0[1]}), b = gelu_pk((f32x2){v0[2], v0[3]}), c = gelu_pk((f32x2){v1[0], v1[1]}), d = gelu_pk((f32x2){v1[2], v1[3]});
                        v0 = (f32x4){a.x, a.y, b.x, b.y}; v1 = (f32x4){c.x, c.y, d.x, d.y};
                        ss += (v0[0] * v0[0] + v0[1] * v0[1]) + (v0[2] * v0[2] + v0[3] * v0[3]) + (v1[0] * v1[0] + v1[1] * v1[1]) + (v1[2] * v1[2] + v1[3] * v1[3]); }
                    else if (grp >= 4) { const float rc = r * -1.44269504089f; const f32x4 e0 = acc[ai][bj][m][0] * rc, e1 = acc[ai][bj][m][1] * rc;
#pragma unroll
                        for (int j = 0; j < 4; ++j) { v0[j] = __builtin_amdgcn_rcpf(1.0f + __builtin_amdgcn_exp2f(e0[j])); v1[j] = __builtin_amdgcn_rcpf(1.0f + __builtin_amdgcn_exp2f(e1[j])); } }
                    u32x4 w; w.x = cvt_pk_bf16(v0[0], v0[1]); w.y = cvt_pk_bf16(v0[2], v0[3]); w.z = cvt_pk_bf16(v1[0], v1[1]); w.w = cvt_pk_bf16(v1[2], v1[3]);
                    *(u32x4*)(dst + (size_t)row * 1024 + col0 + bj * HALF) = w; }
                if (grp == 1) { ss += __shfl_xor(ss, 16); ss += __shfl_xor(ss, 32); if (fq == 0) ssv[(size_t)row * 16 + (u.pn & 3) * 4 + wc] = ss; } }
    }
};
template <int MODE> struct EpiMerge {
    static constexpr bool PERM = true, AFTER_DRAIN = false;
    bf16_t* io; const bf16_t* gb;
    __device__ __forceinline__ void operator()(const f32x4 (&acc)[2][2][4][2], const Unit& u, int wr, int wc, int fr, int fq) const {
        const int row0 = u.pm * BM + wr * 64 + fr, col0 = u.pn * BM + wc * 32 + 8 * fq;
        constexpr int MB_ = (MODE == 0) ? 4 : 2;
#pragma unroll
        for (int ai = 0; ai < 2; ++ai)
#pragma unroll
            for (int m0 = 0; m0 < 4; m0 += MB_) {
                u32x4 a[MB_][2], g[MB_][2];
#pragma unroll
                for (int mm = 0; mm < MB_; ++mm)
#pragma unroll
                    for (int bj = 0; bj < 2; ++bj) { const size_t off = (size_t)(row0 + ai * HALF + (m0 + mm) * 16) * 1024 + col0 + bj * HALF;
                        a[mm][bj] = *(const u32x4*)(io + off); if (MODE == 1) g[mm][bj] = *(const u32x4*)(gb + off); }
#pragma unroll
                for (int mm = 0; mm < MB_; ++mm)
#pragma unroll
                    for (int bj = 0; bj < 2; ++bj) { const int m = m0 + mm; const size_t off = (size_t)(row0 + ai * HALF + m * 16) * 1024 + col0 + bj * HALF;
                        const u32x4 x = a[mm][bj]; const f32x4 v0 = acc[ai][bj][m][0], v1 = acc[ai][bj][m][1]; f32x4 o0, o1;
                        if (MODE == 0) { o0 = (f32x4){bf_lo(x.x) * v0[0], bf_hi(x.x) * v0[1], bf_lo(x.y) * v0[2], bf_hi(x.y) * v0[3]}; o1 = (f32x4){bf_lo(x.z) * v1[0], bf_hi(x.z) * v1[1], bf_lo(x.w) * v1[2], bf_hi(x.w) * v1[3]}; }
                        else { const u32x4 y = g[mm][bj];
                            o0 = (f32x4){bf_lo(x.x) + bf_lo(y.x) * v0[0], bf_hi(x.x) + bf_hi(y.x) * v0[1], bf_lo(x.y) + bf_lo(y.y) * v0[2], bf_hi(x.y) + bf_hi(y.y) * v0[3]};
                            o1 = (f32x4){bf_lo(x.z) + bf_lo(y.z) * v1[0], bf_hi(x.z) + bf_hi(y.z) * v1[1], bf_lo(x.w) + bf_lo(y.w) * v1[2], bf_hi(x.w) + bf_hi(y.w) * v1[3]}; }
                        u32x4 w; w.x = cvt_pk_bf16(o0[0], o0[1]); w.y = cvt_pk_bf16(o0[2], o0[3]); w.z = cvt_pk_bf16(o1[0], o1[1]); w.w = cvt_pk_bf16(o1[2], o1[3]);
                        *(u32x4*)(io + off) = w; }
                asm volatile("" ::: "memory"); }
    }
};

template <class Epi, class Sched, bool ALIGN_EPI = false, bool SP2 = false>
__device__ __forceinline__ void gemm_phase(PG8_LAS unsigned char* lds, const Gemm g, const Sched& S, const Epi& E, const int tid_in) {
    const int tid = tid_in, wid = __builtin_amdgcn_readfirstlane(tid >> 6), lane = tid & 63, wr = wid >> 2, wc = wid & 3, fr = lane & 15, fq = lane >> 4;
    const int K = g.K, nt = K / BK;
    unsigned voffA[2], voffB[2];
#pragma unroll
    for (int i = 0; i < 2; ++i) { int R, C; stage_rc(tid * 16 + i * 8192, R, C); const int Rb = Epi::PERM ? ((R & ~31) + perm32(R & 31)) : R;
        voffA[i] = (unsigned)(R * K + C) * 2u; voffB[i] = (unsigned)(Rb * K + C) * 2u; }
    const size_t kstep = (size_t)(BK * 2);
    const size_t hstep = (size_t)HALF * K * 2;
    const size_t tstep = 2 * hstep;
    const unsigned ldsw = (unsigned)wid * 1024u;
    const int aoff = lds_byte(wr * 64 + fr, fq * 8), boff = lds_byte(wc * 32 + fr, fq * 8);
#define PG8_SA(b, h) (((b) * 2 + (h)) * HTB)
#define PG8_SB(b, h) ((4 + (b) * 2 + (h)) * HTB)
#define PG8_STAGE(bufoff, gbase, voff) do { _Pragma("unroll") for (int _i = 0; _i < 2; ++_i) \
        __builtin_amdgcn_global_load_lds((const unsigned*)((const char*)(gbase) + (voff)[_i]), (PG8_LAS unsigned*)(lds + (bufoff) + ldsw + _i * 8192), 16, 0, 0); } while (0)
#define PG8_LDA(dst, b, h) do { _Pragma("unroll") for (int m = 0; m < 4; ++m) _Pragma("unroll") for (int k = 0; k < 2; ++k) dst[m][k] = *(const PG8_LAS bf16x8*)(lds + PG8_SA(b, h) + aoff + m * 2048 + k * 1024); } while (0)
#define PG8_LDB(dst, b, h) do { _Pragma("unroll") for (int n = 0; n < 2; ++n) _Pragma("unroll") for (int k = 0; k < 2; ++k) dst[n][k] = *(const PG8_LAS bf16x8*)(lds + PG8_SB(b, h) + boff + n * 2048 + k * 1024); } while (0)
#define PG8_MMA(ai, bj, At, Bt) do { __builtin_amdgcn_s_setprio(1); _Pragma("unroll") for (int m = 0; m < 4; ++m) _Pragma("unroll") for (int n = 0; n < 2; ++n) _Pragma("unroll") for (int k = 0; k < 2; ++k) \
        acc[ai][bj][m][n] = __builtin_amdgcn_mfma_f32_16x16x32_bf16(Bt[n][k], At[m][k], acc[ai][bj][m][n], 0, 0, 0); __builtin_amdgcn_s_setprio(0); } while (0)
#define PG8_WAIT_V(n) asm volatile("s_waitcnt vmcnt(" #n ")" ::: "memory")
#define PG8_WAIT_L(n) asm volatile("s_waitcnt lgkmcnt(" #n ")" ::: "memory")
#define PG8_BAR __builtin_amdgcn_s_barrier()
#define PG8_SCHED __builtin_amdgcn_sched_barrier(0)
    Unit cur, nxt; int ui = 0;
    if (!S.next(0, cur)) return;
    f32x4 acc[2][2][4][2];
#pragma unroll
    for (int a = 0; a < 2; ++a)
#pragma unroll
        for (int b = 0; b < 2; ++b)
#pragma unroll
            for (int m = 0; m < 4; ++m)
#pragma unroll
                for (int n = 0; n < 2; ++n) acc[a][b][m][n] = (f32x4){0.f, 0.f, 0.f, 0.f};
    bf16x8 At[4][2], B0[2][2], B1[2][2];
    const char* cA = (const char*)g.A + (size_t)cur.pm * tstep; const char* cB = (const char*)g.Bt + (size_t)cur.pn * tstep;
    S.a_ready(cur);
    if constexpr (SP2) {
        PG8_STAGE(PG8_SB(0, 0), cB, voffB); PG8_STAGE(PG8_SB(0, 1), cB + hstep, voffB); PG8_STAGE(PG8_SA(0, 0), cA, voffA); PG8_STAGE(PG8_SA(0, 1), cA + hstep, voffA);
        PG8_STAGE(PG8_SB(1, 0), cB + kstep, voffB); PG8_STAGE(PG8_SA(1, 0), cA + kstep, voffA); PG8_STAGE(PG8_SB(1, 1), cB + hstep + kstep, voffB);
        if (wr == 1) PG8_BAR;
        PG8_WAIT_V(8); PG8_BAR;
        PG8_WAIT_V(6); PG8_BAR;
    } else {
        PG8_STAGE(PG8_SB(0, 0), cB, voffB); PG8_STAGE(PG8_SA(0, 0), cA, voffA); PG8_STAGE(PG8_SB(0, 1), cB + hstep, voffB); PG8_STAGE(PG8_SA(0, 1), cA + hstep, voffA);
        if (wr == 1) PG8_BAR;
        PG8_WAIT_V(4); PG8_BAR;
        PG8_STAGE(PG8_SB(1, 0), cB + kstep, voffB); PG8_STAGE(PG8_SA(1, 0), cA + kstep, voffA); PG8_STAGE(PG8_SB(1, 1), cB + hstep + kstep, voffB);
        PG8_WAIT_V(6); PG8_BAR;
    }
    for (;;) {
        const bool has_next = S.next(ui + 1, nxt);
        const char* nA = has_next ? (const char*)g.A + (size_t)nxt.pm * tstep : cA; const char* nB = has_next ? (const char*)g.Bt + (size_t)nxt.pn * tstep : cB;
        for (int t = 0; t < nt; t += 2) {
            const bool last = (t == nt - 2);
            const char* a1 = cA + (size_t)(t + 1) * kstep;
            const char* a2 = last ? nA : cA + (size_t)(t + 2) * kstep; const char* b2 = last ? nB : cB + (size_t)(t + 2) * kstep;
            const char* a3 = a2 + kstep; const char* b3 = b2 + kstep;
            if (last && has_next) S.a_ready(nxt);
            if constexpr (SP2) {
            PG8_LDB(B0, 0, 0); PG8_LDB(B1, 0, 1); PG8_SCHED; PG8_LDA(At, 0, 0); PG8_STAGE(PG8_SA(1, 1), a1 + hstep, voffA);
            PG8_WAIT_V(8); PG8_WAIT_L(0); PG8_BAR; PG8_MMA(0, 0, At, B0); PG8_MMA(0, 1, At, B1); PG8_BAR; PG8_SCHED;
            PG8_LDA(At, 0, 1); PG8_STAGE(PG8_SB(0, 0), b2, voffB); PG8_STAGE(PG8_SB(0, 1), b2 + hstep, voffB); PG8_STAGE(PG8_SA(0, 0), a2, voffA);
            PG8_WAIT_V(8); PG8_WAIT_L(0); PG8_BAR; PG8_MMA(1, 0, At, B0); PG8_MMA(1, 1, At, B1); PG8_BAR; PG8_SCHED;
            PG8_LDB(B0, 1, 0); PG8_LDB(B1, 1, 1); PG8_SCHED; PG8_LDA(At, 1, 0); PG8_STAGE(PG8_SA(0, 1), a2 + hstep, voffA);
            PG8_WAIT_V(8); PG8_WAIT_L(0); PG8_BAR; PG8_MMA(0, 0, At, B0); PG8_MMA(0, 1, At, B1); PG8_BAR; PG8_SCHED;
            PG8_LDA(At, 1, 1); PG8_STAGE(PG8_SB(1, 0), b3, voffB); PG8_STAGE(PG8_SB(1, 1), b3 + hstep, voffB); PG8_STAGE(PG8_SA(1, 0), a3, voffA);
            PG8_WAIT_V(8); PG8_WAIT_L(0); PG8_BAR; PG8_MMA(1, 0, At, B0); PG8_MMA(1, 1, At, B1); PG8_BAR; PG8_SCHED;
            } else {
            PG8_LDB(B0, 0, 0); PG8_SCHED; PG8_LDA(At, 0, 0); PG8_STAGE(PG8_SA(1, 1), a1 + hstep, voffA);
            PG8_WAIT_L(8); PG8_BAR; PG8_WAIT_L(0); PG8_MMA(0, 0, At, B0); PG8_BAR; PG8_SCHED;
            PG8_LDB(B1, 0, 1); PG8_STAGE(PG8_SB(0, 0), b2, voffB);
            PG8_BAR; PG8_WAIT_L(0); PG8_MMA(0, 1, At, B1); PG8_BAR;
            PG8_LDA(At, 0, 1); PG8_STAGE(PG8_SA(0, 0), a2, voffA);
            PG8_BAR; PG8_WAIT_L(0); PG8_MMA(1, 0, At, B0); PG8_BAR; PG8_SCHED;
            PG8_STAGE(PG8_SB(0, 1), b2 + hstep, voffB);
            PG8_WAIT_V(6); PG8_BAR; PG8_MMA(1, 1, At, B1); PG8_BAR;
            PG8_LDB(B0, 1, 0); PG8_SCHED; PG8_LDA(At, 1, 0); PG8_STAGE(PG8_SA(0, 1), a2 + hstep, voffA);
            PG8_WAIT_L(8); PG8_BAR; PG8_WAIT_L(0); PG8_MMA(0, 0, At, B0); PG8_BAR; PG8_SCHED;
            PG8_LDB(B1, 1, 1); PG8_STAGE(PG8_SB(1, 0), b3, voffB);
            PG8_BAR; PG8_WAIT_L(0); PG8_MMA(0, 1, At, B1); PG8_BAR;
            PG8_LDA(At, 1, 1); PG8_STAGE(PG8_SA(1, 0), a3, voffA);
            PG8_BAR; PG8_WAIT_L(0); PG8_MMA(1, 0, At, B0); PG8_BAR; PG8_SCHED;
            PG8_STAGE(PG8_SB(1, 1), b3 + hstep, voffB);
            PG8_WAIT_V(6); PG8_BAR; PG8_MMA(1, 1, At, B1); PG8_BAR;
            }
        }
        if constexpr (ALIGN_EPI) { if (wr == 0) PG8_BAR; }
        if constexpr (!Epi::AFTER_DRAIN) { E(acc, cur, wr, wc, fr, fq); S.done(cur); }
        if (!has_next) break;
#pragma unroll
        for (int a = 0; a < 2; ++a)
#pragma unroll
            for (int b = 0; b < 2; ++b)
#pragma unroll
                for (int m = 0; m < 4; ++m)
#pragma unroll
                    for (int n = 0; n < 2; ++n) acc[a][b][m][n] = (f32x4){0.f, 0.f, 0.f, 0.f};
        cur = nxt; cA = nA; cB = nB; ++ui;
        if constexpr (ALIGN_EPI) { if (wr == 1) PG8_BAR; }
    }
    PG8_WAIT_V(0);
    if constexpr (!ALIGN_EPI) { if (wr == 0) PG8_BAR; }
    PG8_BAR;
    if constexpr (Epi::AFTER_DRAIN) { E.fused(acc, cur, wr, wc, fr, fq, lds, wid, lane); S.done(cur); }
#undef PG8_SA
#undef PG8_SB
#undef PG8_STAGE
#undef PG8_LDA
#undef PG8_LDB
#undef PG8_MMA
#undef PG8_WAIT_V
#undef PG8_WAIT_L
#undef PG8_BAR
#undef PG8_SCHED
}
}

#ifndef MK_PER_PHASE
#define MK_PER_PHASE 0
#endif
#define LAS __attribute__((address_space(3)))
typedef unsigned short bf16;
typedef unsigned v4u __attribute__((ext_vector_type(4)));
typedef unsigned v2u __attribute__((ext_vector_type(2)));
typedef float f32x4 __attribute__((ext_vector_type(4)));
typedef short bf16x8 __attribute__((ext_vector_type(8)));
typedef short s16x4 __attribute__((ext_vector_type(4)));
#define LDS_WAIT() asm volatile("s_waitcnt lgkmcnt(0)" ::: "memory")

constexpr int D = 1024, DFF = 2816, MP = 32768  , NPASS = 2, DEPTH = 2;
constexpr int NWAVES = 8, NTHR = 512;
constexpr float EPS = 1e-6f;
constexpr size_t WS_F1 = 65536, WS_F2P = WS_F1 + 131072, WS_F2S = WS_F2P + 65536;
constexpr size_t WS_WL0 = 1048576;
constexpr size_t L_WGU1 = 0, L_WD1 = L_WGU1 + (size_t)2 * DFF * D * 2, L_WIN = L_WD1 + (size_t)D * DFF * 2, L_WA = L_WIN + (size_t)6144 * D * 2,
                 L_WB = L_WA + (size_t)D * D * 2, L_WO = L_WB + (size_t)D * D * 2, L_WGU2 = L_WO + (size_t)D * D * 2, L_WD2 = L_WGU2 + (size_t)2 * DFF * D * 2,
                 L_WS = L_WD2 + (size_t)D * DFF * 2, LAYER_BYTES = L_WS + (size_t)8 * 128 * 128 * 2;
constexpr size_t WS_XB = WS_WL0 + DEPTH * LAYER_BYTES, WS_SSP = WS_XB + (size_t)MP * D * 2, WS_SSV = WS_SSP + (size_t)NPASS * MP * 16 * 4,
                 WS_BIG = WS_SSV + (size_t)MP * 16 * 4, ACT_BYTES = (size_t)MP * D * 2, WS_END = WS_BIG + 4 * ACT_BYTES;
static_assert(WS_END <= (size_t)512 * 1024 * 1024, "workspace budget");
static_assert((size_t)MP * DFF * 2 <= 4 * ACT_BYTES, "H overlays U|V|P|Q");
constexpr int LDS_BYTES = 135168, XB_LDS_OFF = 131072 + 256;

__device__ __forceinline__ unsigned f2bf(float f) { unsigned u = __builtin_bit_cast(unsigned, f); return (u + 0x7fffu + ((u >> 16) & 1u)) >> 16; }
__device__ __forceinline__ unsigned pk2(float lo, float hi) { return pg8::cvt_pk_bf16(lo, hi); }
__device__ __forceinline__ float bflo(unsigned w) { return __builtin_bit_cast(float, w << 16); }
__device__ __forceinline__ float bfhi(unsigned w) { return __builtin_bit_cast(float, w & 0xffff0000u); }
__device__ __forceinline__ float wave_sum(float v) {
#pragma unroll
    for (int o = 1; o < 64; o <<= 1) v += __shfl_xor(v, o);
    return v;
}

__device__ __forceinline__ void tr_item(const float* W, int ldw, int c0, int K, int ncols, const float* gain, bf16* dst, int rmode, int rbase, LAS float* scr, int item, int lane) {
    const int nblk = ncols / 32, kb = item / nblk, nb = item % nblk, k0 = 64 * kb, n0 = 32 * nb;
#pragma unroll
    for (int i = 0; i < 32; ++i) { const int kk = 2 * i + (lane >> 5); const float g = gain ? gain[k0 + kk] : 1.0f; scr[kk * 33 + (lane & 31)] = g * __builtin_nontemporal_load(W + (size_t)(k0 + kk) * ldw + c0 + n0 + (lane & 31)); }
    LDS_WAIT(); asm volatile("" ::: "memory");
    const int c = lane & 7;
#pragma unroll
    for (int j = 0; j < 4; ++j) { const int n = (lane >> 3) + 8 * j; const LAS float* s = scr + (8 * c) * 33 + n;
        v4u o; o.x = pk2(s[0 * 33], s[1 * 33]); o.y = pk2(s[2 * 33], s[3 * 33]); o.z = pk2(s[4 * 33], s[5 * 33]); o.w = pk2(s[6 * 33], s[7 * 33]);
        const int nn = n0 + n; const int drow = rmode ? ((nn >> 7) * 256 + (nn & 127) + rbase) : (nn + rbase);
        *(v4u*)(dst + (size_t)drow * K + k0 + 8 * c) = o; }
    LDS_WAIT(); asm volatile("" ::: "memory");
}
__device__ __forceinline__ void fold_item(const float* win, const float* gmix, bf16* wint, LAS unsigned char* lds, int g, int kb) {
    LAS float* wl = (LAS float*)lds; LAS float* tab = wl + 32 * 256; const int tid = threadIdx.x, k0 = 32 * kb;
    for (int idx = tid; idx < 32 * 256; idx += NTHR) { const int kk = idx >> 8, c = idx & 255; wl[idx] = gmix[k0 + kk] * win[(size_t)(k0 + kk) * 5120 + 2048 + g * 256 + c]; }
    if (tid < 256) tab[tid] = cospif((float)tid * (1.0f / 128.0f)) * 0.0625f;
    __syncthreads();
    const int j = tid & 255, half = tid >> 8;
    float aP[16], aQ[16];
#pragma unroll
    for (int kk = 0; kk < 16; ++kk) { aP[kk] = 0.f; aQ[kk] = 0.f; }
    const LAS f32x4* wl4 = (const LAS f32x4*)wl + (half * 16) * 64;
#pragma unroll 1
    for (int c4 = 0; c4 < 64; ++c4) { float cs[4], sn[4];
#pragma unroll
        for (int e = 0; e < 4; ++e) { const int m = ((4 * c4 + e) * j) & 255; cs[e] = tab[m]; sn[e] = tab[(m + 192) & 255]; }
#pragma unroll
        for (int kk = 0; kk < 16; ++kk) { const f32x4 w = wl4[kk * 64 + c4];
#pragma unroll
            for (int e = 0; e < 4; ++e) { aP[kk] += w[e] * cs[e]; aQ[kk] += w[e] * sn[e]; } } }
    bf16* dP = wint + (size_t)(2048 + g * 256 + j) * 1024 + k0 + half * 16; bf16* dQ = dP + (size_t)1024 * 1024;
    v4u o; o.x = pk2(aP[0], aP[1]); o.y = pk2(aP[2], aP[3]); o.z = pk2(aP[4], aP[5]); o.w = pk2(aP[6], aP[7]); *(v4u*)dP = o;
    o.x = pk2(aP[8], aP[9]); o.y = pk2(aP[10], aP[11]); o.z = pk2(aP[12], aP[13]); o.w = pk2(aP[14], aP[15]); *(v4u*)(dP + 8) = o;
    o.x = pk2(aQ[0], aQ[1]); o.y = pk2(aQ[2], aQ[3]); o.z = pk2(aQ[4], aQ[5]); o.w = pk2(aQ[6], aQ[7]); *(v4u*)dQ = o;
    o.x = pk2(aQ[8], aQ[9]); o.y = pk2(aQ[10], aQ[11]); o.z = pk2(aQ[12], aQ[13]); o.w = pk2(aQ[14], aQ[15]); *(v4u*)(dQ + 8) = o;
    __syncthreads();
}
__device__ __forceinline__ void x0_rows(const float* xin, bf16* xb, float* ssp, int gw, int ngw, int lane) {
    for (int row = gw; row < MP; row += ngw) { const f32x4* xr = (const f32x4*)(xin + (size_t)row * D) + lane; f32x4 v[4]; float s = 0.f;
#pragma unroll
        for (int j = 0; j < 4; ++j) { v[j] = __builtin_nontemporal_load(xr + 64 * j); s += (v[j][0] * v[j][0] + v[j][1] * v[j][1]) + (v[j][2] * v[j][2] + v[j][3] * v[j][3]); }
        s = wave_sum(s);
        v2u* o = (v2u*)(xb + (size_t)row * D) + lane;
#pragma unroll
        for (int j = 0; j < 4; ++j) { v2u w; w.x = pk2(v[j][0], v[j][1]); w.y = pk2(v[j][2], v[j][3]); o[64 * j] = w; }
        if (lane < 16) ssp[(size_t)row * 16 + lane] = lane == 0 ? s : 0.f; }
}
__device__ __forceinline__ void final_rows(float* out, const bf16* xb, const float* ssp, const float* gfin, int gw, int ngw, int lane) {
    for (int row = gw; row < MP; row += ngw) { const f32x4* sp = (const f32x4*)(ssp + (size_t)row * 16); const f32x4 a = sp[0], b = sp[1], c = sp[2], d = sp[3];
        const float ss = ((a[0] + a[1]) + (a[2] + a[3])) + ((b[0] + b[1]) + (b[2] + b[3])) + ((c[0] + c[1]) + (c[2] + c[3])) + ((d[0] + d[1]) + (d[2] + d[3]));
        const float r = 1.0f / sqrtf(ss * (1.0f / D) + EPS);
        f32x4* orow = (f32x4*)(out + (size_t)row * D) + lane; const f32x4* gr = (const f32x4*)gfin + lane; const v2u* xr = (const v2u*)(xb + (size_t)row * D) + lane;
#pragma unroll
        for (int j = 0; j < 4; ++j) { const v2u w = xr[64 * j]; const f32x4 g = gr[64 * j]; const f32x4 v = (f32x4){bflo(w.x), bfhi(w.x), bflo(w.y), bfhi(w.y)}; __builtin_nontemporal_store(v * r * g, orow + 64 * j); } }
}

__device__ __forceinline__ unsigned off_b(unsigned row, unsigned ch) { return 256u * row + 16u * (ch ^ (((row & 3u) << 2) | ((row >> 2) & 3u))); }
template <int MB, int KK, class RP, class XF, class EP>
__device__ __forceinline__ void smm_tile(LAS unsigned char* lds, const bf16* Amat, const RP& rp, const XF& xf, const EP& ep, const int tid_in) {
    const int tid = tid_in, wave = __builtin_amdgcn_readfirstlane(tid >> 6), lane = tid & 63;
    { const int ch = tid & 15, r0 = tid >> 4; v4u v[KK / 32];
#pragma unroll
      for (int i = 0; i < KK / 32; ++i) v[i] = *(const v4u*)(rp(r0 + 32 * i) + ch * 8);
#pragma unroll
      for (int i = 0; i < KK / 32; ++i) { const v4u t = xf(r0 + 32 * i, ch, v[i]); *(LAS v4u*)(lds + off_b(r0 + 32 * i, ch)) = t; } }
    __syncthreads();
    bf16x8 a[MB][KK / 32];
    const bf16* ap = Amat + (size_t)(wave * 16 + (lane & 15)) * KK + (lane >> 4) * 8;
#pragma unroll
    for (int mb = 0; mb < MB; ++mb)
#pragma unroll
        for (int kb = 0; kb < KK / 32; ++kb) a[mb][kb] = *(const bf16x8*)(ap + (size_t)mb * 128 * KK + kb * 32);
    f32x4 acc[MB][8];
#pragma unroll
    for (int mb = 0; mb < MB; ++mb)
#pragma unroll
        for (int nb = 0; nb < 8; ++nb) acc[mb][nb] = (f32x4){0.f, 0.f, 0.f, 0.f};
    const unsigned g = lane >> 4, q = (lane & 15) >> 2, p = lane & 3;
#pragma unroll
    for (int nb = 0; nb < 8; ++nb) {
        bf16x8 b[KK / 32];
#pragma unroll
        for (int kb = 0; kb < KK / 32; ++kb) { const unsigned rA = 32u * kb + 8u * g + q;
            const s16x4 lo = __builtin_amdgcn_ds_read_tr16_b64_v4i16((LAS s16x4*)(lds + off_b(rA, 4 * (nb >> 1) + p) + 8 * (nb & 1)));
            const s16x4 hi = __builtin_amdgcn_ds_read_tr16_b64_v4i16((LAS s16x4*)(lds + off_b(rA + 4, 4 * (nb >> 1) + p) + 8 * (nb & 1)));
            b[kb] = __builtin_shufflevector(lo, hi, 0, 1, 2, 3, 4, 5, 6, 7); }
#pragma unroll
        for (int kb = 0; kb < KK / 32; ++kb)
#pragma unroll
            for (int mb = 0; mb < MB; ++mb) acc[mb][nb] = __builtin_amdgcn_mfma_f32_16x16x32_bf16(b[kb], a[mb][kb], acc[mb][nb], 0, 0, 0); }
    ep(acc, wave, lane);
    __syncthreads();
}
__device__ __forceinline__ void fold_tile(LAS unsigned char* lds, const float* win, const float* gmix, bf16* wint, int g, int kt, int which, const int tid_in) {
    const int tid = tid_in, wave = __builtin_amdgcn_readfirstlane(tid >> 6), lane = tid & 63, k0 = 128 * kt;
    LAS float* tab = (LAS float*)(lds + 65536);
    if (tid < 256) tab[tid] = cospif((float)tid * (1.0f / 128.0f)) * 0.0625f;
    { const int c4 = 4 * lane;
#pragma unroll 4
      for (int i = 0; i < 16; ++i) { const int k = wave + 8 * i; const f32x4 w = *(const f32x4*)(win + (size_t)(k0 + k) * 5120 + 2048 + g * 256 + c4) * gmix[k0 + k];
#pragma unroll
          for (int e = 0; e < 4; ++e) *(LAS unsigned short*)(lds + off_b((unsigned)(c4 + e), (unsigned)(k >> 3)) + (k & 7) * 2) = (unsigned short)f2bf(w[e]); } }
    __syncthreads();
    bf16x8 a[2][8];
    { const int sh = which ? 192 : 0;
#pragma unroll
      for (int mb = 0; mb < 2; ++mb) { const int j = mb * 128 + wave * 16 + (lane & 15);
#pragma unroll
        for (int kb = 0; kb < 8; ++kb) { const int c0 = kb * 32 + (lane >> 4) * 8; unsigned wv[4];
#pragma unroll
            for (int e2 = 0; e2 < 4; ++e2) { const float t0 = tab[(((c0 + 2 * e2) * j) + sh) & 255], t1 = tab[(((c0 + 2 * e2 + 1) * j) + sh) & 255]; wv[e2] = pk2(t0, t1); }
            v4u pv; pv.x = wv[0]; pv.y = wv[1]; pv.z = wv[2]; pv.w = wv[3]; a[mb][kb] = __builtin_bit_cast(bf16x8, pv); } } }
    f32x4 acc[2][8];
#pragma unroll
    for (int mb = 0; mb < 2; ++mb)
#pragma unroll
        for (int nb = 0; nb < 8; ++nb) acc[mb][nb] = (f32x4){0.f, 0.f, 0.f, 0.f};
    const unsigned gq = lane >> 4, q = (lane & 15) >> 2, p = lane & 3;
#pragma unroll
    for (int nb = 0; nb < 8; ++nb) {
        bf16x8 b[8];
#pragma unroll
        for (int kb = 0; kb < 8; ++kb) { const unsigned rA = 32u * kb + 8u * gq + q;
            const s16x4 lo = __builtin_amdgcn_ds_read_tr16_b64_v4i16((LAS s16x4*)(lds + off_b(rA, 4 * (nb >> 1) + p) + 8 * (nb & 1)));
            const s16x4 hi = __builtin_amdgcn_ds_read_tr16_b64_v4i16((LAS s16x4*)(lds + off_b(rA + 4, 4 * (nb >> 1) + p) + 8 * (nb & 1)));
            b[kb] = __builtin_shufflevector(lo, hi, 0, 1, 2, 3, 4, 5, 6, 7); }
#pragma unroll
        for (int kb = 0; kb < 8; ++kb)
#pragma unroll
            for (int mb = 0; mb < 2; ++mb) acc[mb][nb] = __builtin_amdgcn_mfma_f32_16x16x32_bf16(b[kb], a[mb][kb], acc[mb][nb], 0, 0, 0); }
    const int fq = lane >> 4;
#pragma unroll
    for (int mb = 0; mb < 2; ++mb) { const int j = mb * 128 + wave * 16 + (lane & 15); bf16* dst = wint + (size_t)((which ? 3072 : 2048) + g * 256 + j) * 1024 + k0 + fq * 8;
#pragma unroll
        for (int G4 = 0; G4 < 4; ++G4) { const f32x4 y0 = acc[mb][2 * G4], y1 = acc[mb][2 * G4 + 1]; v4u w; w.x = pk2(y0[0], y0[1]); w.y = pk2(y0[2], y0[3]); w.z = pk2(y1[0], y1[1]); w.w = pk2(y1[2], y1[3]); *(v4u*)(dst + G4 * 32) = w; } }
    __syncthreads();
}
struct XfNone { __device__ __forceinline__ v4u operator()(int, int, v4u v) const { return v; } };
struct SguRP { const bf16* base; __device__ __forceinline__ const bf16* operator()(int r) const { return base + (size_t)r * D; } };
struct SguXF { const float* ssv; const float* gv;
    __device__ __forceinline__ v4u operator()(int r, int ch, v4u v) const {
        const f32x4* sp = (const f32x4*)(ssv + (size_t)r * 16); const f32x4 a = sp[0], b = sp[1], c = sp[2], d = sp[3];
        const float ss = ((a[0] + a[1]) + (a[2] + a[3])) + ((b[0] + b[1]) + (b[2] + b[3])) + ((c[0] + c[1]) + (c[2] + c[3])) + ((d[0] + d[1]) + (d[2] + d[3]));
        const float rs = 1.0f / sqrtf(ss * (1.0f / 1024.0f) + EPS);
        const f32x4 g0 = *(const f32x4*)(gv + ch * 8) * rs, g1 = *(const f32x4*)(gv + ch * 8 + 4) * rs;
        v4u o; o.x = pk2(bflo(v.x) * g0[0], bfhi(v.x) * g0[1]); o.y = pk2(bflo(v.y) * g0[2], bfhi(v.y) * g0[3]);
        o.z = pk2(bflo(v.z) * g1[0], bfhi(v.z) * g1[1]); o.w = pk2(bflo(v.w) * g1[2], bfhi(v.w) * g1[3]); return o; } };
struct SguEP { bf16* ubase; const float* bs;
    __device__ __forceinline__ void operator()(const f32x4 (&acc)[1][8], int wave, int lane) const {
        const int p = wave * 16 + (lane & 15), fq = lane >> 4; const float bias = bs[p];
        v4u uu[4];
#pragma unroll
        for (int G4 = 0; G4 < 4; ++G4) uu[G4] = *(const v4u*)(ubase + (size_t)p * D + G4 * 32 + fq * 8);
#pragma unroll
        for (int G4 = 0; G4 < 4; ++G4) { const f32x4 y0 = acc[0][2 * G4] + bias, y1 = acc[0][2 * G4 + 1] + bias; const v4u u = uu[G4];
            v4u o; o.x = pk2(bflo(u.x) * y0[0], bfhi(u.x) * y0[1]); o.y = pk2(bflo(u.y) * y0[2], bfhi(u.y) * y0[3]);
            o.z = pk2(bflo(u.z) * y1[0], bfhi(u.z) * y1[1]); o.w = pk2(bflo(u.w) * y1[2], bfhi(u.w) * y1[3]);
            *(v4u*)(ubase + (size_t)p * D + G4 * 32 + fq * 8) = o; } } };
struct F1RP { const bf16* pb; const bf16* qb; int n2s; __device__ __forceinline__ const bf16* operator()(int r) const { return ((r >> 7) ? qb : pb) + (size_t)((r & 127) * n2s) * D; } };
struct F1EP { bf16* pb; bf16* qb; int n2s, n2; float invS2;
    __device__ __forceinline__ void operator()(const f32x4 (&acc)[2][8], int wave, int lane) const {
        const int k1 = wave * 16 + (lane & 15), fq = lane >> 4; float sn, cs; sincospif((float)(n2 * k1) * invS2, &sn, &cs);
        bf16* po = pb + (size_t)(k1 * n2s) * D + fq * 8; bf16* qo = qb + (size_t)(k1 * n2s) * D + fq * 8;
#pragma unroll
        for (int G4 = 0; G4 < 4; ++G4) { const f32x4 ar0 = acc[0][2 * G4], ai0 = acc[1][2 * G4], ar1 = acc[0][2 * G4 + 1], ai1 = acc[1][2 * G4 + 1];
            const f32x4 pr0 = ar0 * cs - ai0 * sn, pi0 = ar0 * sn + ai0 * cs, pr1 = ar1 * cs - ai1 * sn, pi1 = ar1 * sn + ai1 * cs;
            v4u o; o.x = pk2(pr0[0], pr0[1]); o.y = pk2(pr0[2], pr0[3]); o.z = pk2(pr1[0], pr1[1]); o.w = pk2(pr1[2], pr1[3]); *(v4u*)(po + G4 * 32) = o;
            o.x = pk2(pi0[0], pi0[1]); o.y = pk2(pi0[2], pi0[3]); o.z = pk2(pi1[0], pi1[1]); o.w = pk2(pi1[2], pi1[3]); *(v4u*)(qo + G4 * 32) = o; } } };
struct F2RP { const bf16* pb; const bf16* qb; __device__ __forceinline__ const bf16* operator()(int r) const { return ((r >> 7) ? qb : pb) + (size_t)(r & 127) * D; } };
struct F2EP { bf16* fb; int blk, sample;
    __device__ __forceinline__ void operator()(const f32x4 (&acc)[1][8], int wave, int lane) const {
        const int o = wave * 16 + (lane & 15), fq = lane >> 4; const int k = sample ? (4 * blk + (o >> 5)) + 128 * (o & 31) : blk + 128 * o;
        bf16* fo = fb + (size_t)k * D + fq * 8;
#pragma unroll
        for (int G4 = 0; G4 < 4; ++G4) { const f32x4 y0 = acc[0][2 * G4], y1 = acc[0][2 * G4 + 1]; v4u w; w.x = pk2(y0[0], y0[1]); w.y = pk2(y0[2], y0[3]); w.z = pk2(y1[0], y1[1]); w.w = pk2(y1[2], y1[3]); *(v4u*)(fo + G4 * 32) = w; } } };

#define XB_TMO      128
#define XB_XCNT(j)  (256  + 64 * (j))
#define XB_XSUB(j)  (1280 + 64 * (j))
#define XB_XGEN(j)  (2304 + 64 * (j))
#define XB_TOP      3328
#define XB_TOPGEN   3392
#define XCD_BAR_WORDS 3456
#define XB_SPIN_CAP (1u << 18)

__device__ __forceinline__ unsigned xb_ld(unsigned* p)              { return __hip_atomic_load(p, __ATOMIC_RELAXED, __HIP_MEMORY_SCOPE_AGENT); }
__device__ __forceinline__ unsigned xb_add(unsigned* p, unsigned v) { return __hip_atomic_fetch_add(p, v, __ATOMIC_RELAXED, __HIP_MEMORY_SCOPE_AGENT); }
__device__ __forceinline__ unsigned xb_xcc_id() { return (unsigned)__builtin_amdgcn_s_getreg((3 << 11) | 20) & 0xFu; }
#define XB_SPIN(cond, bar) do { unsigned _sp = 0; while (cond) { __builtin_amdgcn_s_sleep(1); \
    if ((++_sp & 255u) == 0u) { if (xb_ld(&(bar)[XB_TMO])) break; if (_sp > XB_SPIN_CAP) { atomicAdd(&(bar)[XB_TMO], 1u); break; } } } } while (0)

struct XcdBarrier {
    unsigned* bar; unsigned x;
    volatile LAS unsigned* st;
};

__device__ __forceinline__ XcdBarrier xcd_barrier_post(unsigned* bar, volatile LAS unsigned* st) {
    XcdBarrier b; b.bar = bar; b.x = xb_xcc_id(); b.st = st;
    if (threadIdx.x == 0) (void)xb_add(&bar[XB_XCNT(b.x)], 1u);
    return b;
}
__device__ __forceinline__ void xcd_barrier_complete(unsigned* bar, unsigned x, unsigned& nloc, unsigned& nx) {
    const unsigned G = gridDim.x * gridDim.y * gridDim.z;
    unsigned sum, cnt, mine, sp = 0u;
    for (;;) {
        sum = 0u; cnt = 0u; mine = 0u;
#pragma unroll
        for (unsigned j = 0; j < 16; ++j) { const unsigned c = xb_ld(&bar[XB_XCNT(j)]); sum += c; cnt += (c > 0u) ? 1u : 0u; mine = (j == x) ? c : mine; }
        if (sum == G) break;
        __builtin_amdgcn_s_sleep(1);
        if ((++sp & 255u) == 0u) { if (xb_ld(&bar[XB_TMO])) break; if (sp > XB_SPIN_CAP) { atomicAdd(&bar[XB_TMO], 1u); break; } }
    }
    nloc = mine > 0u ? mine : 1u; nx = cnt > 0u ? cnt : 1u;
}

__device__ __forceinline__ void xcd_barrier(const XcdBarrier& b) {
    asm volatile("s_waitcnt vmcnt(0)" ::: "memory");
    __syncthreads();
    if (threadIdx.x == 0) {
        unsigned* bar = b.bar;
        __builtin_amdgcn_s_waitcnt(0);
        unsigned nloc = b.st[0], nx = b.st[1];
        if (nloc == 0u) { xcd_barrier_complete(bar, b.x, nloc, nx); b.st[0] = nloc; b.st[1] = nx; }
        const unsigned old = xb_add(&bar[XB_XSUB(b.x)], 1u);
        const unsigned gen = old / nloc;
        if (old + 1u == (gen + 1u) * nloc) {
            __builtin_amdgcn_fence(__ATOMIC_RELEASE, "agent");
            asm volatile("s_waitcnt vmcnt(0)" ::: "memory");
            const unsigned og = xb_add(&bar[XB_TOP], 1u);
            const unsigned tg = og / nx;
            if (og + 1u == (tg + 1u) * nx) xb_add(&bar[XB_TOPGEN], 1u);
            else XB_SPIN(xb_ld(&bar[XB_TOPGEN]) == tg, bar);
            __builtin_amdgcn_fence(__ATOMIC_ACQUIRE, "agent");
            xb_add(&bar[XB_XGEN(b.x)], 1u);
            asm volatile("s_waitcnt vmcnt(0)" ::: "memory");
        } else {
            XB_SPIN(xb_ld(&bar[XB_XGEN(b.x)]) == gen, bar);
            __builtin_amdgcn_fence(__ATOMIC_ACQUIRE, "agent");
            asm volatile("s_waitcnt vmcnt(0)" ::: "memory");
        }
    }
    __syncthreads();
}


struct Args { const float* in[19]; float* out; unsigned char* ws; int ph_lo, ph_hi; };
constexpr int STEPS = 10, PASS_PH = DEPTH * STEPS + 1, NPHASE = 1 + NPASS * PASS_PH;

__global__ void __launch_bounds__(NTHR, 2) mk_fwd(Args args) {
    extern __shared__ __attribute__((aligned(16))) unsigned char lds_raw[];
    LAS unsigned char* lds = (LAS unsigned char*)lds_raw;
    typedef const __attribute__((address_space(4))) Args* CArgs;
    { volatile LAS unsigned* st0 = (volatile LAS unsigned*)(lds + XB_LDS_OFF); if (threadIdx.x < 2) st0[threadIdx.x] = 0u; __syncthreads();
      if (args.ph_hi - args.ph_lo > 1) (void)xcd_barrier_post((unsigned*)args.ws, st0); }
    const int ph_lo = args.ph_lo, ph_hi = args.ph_hi;
    for (int ph = ph_lo; ph < ph_hi; ++ph) {
        int tidv = threadIdx.x; asm volatile("" : "+v"(tidv));
        CArgs ap = (CArgs)__builtin_amdgcn_kernarg_segment_ptr(); asm volatile("" : "+s"(ap));
        const int tid = tidv, lane = tid & 63, wave = __builtin_amdgcn_readfirstlane(tid >> 6);
        const int G = gridDim.x, bx = blockIdx.x, gw = bx * NWAVES + wave, ngw = G * NWAVES;
        unsigned char* ws = ap->ws;
        bf16* XB = (bf16*)(ws + WS_XB); float* SSV = (float*)(ws + WS_SSV);
        bf16* Ub = (bf16*)(ws + WS_BIG); bf16* Vb = Ub + (size_t)MP * D; bf16* Pb = Vb + (size_t)MP * D; bf16* Qb = Pb + (size_t)MP * D; bf16* Hb = Ub;
        bf16* GAb = (bf16*)(ap->out + (size_t)MP * D); bf16* GBb = GAb + (size_t)MP * D;
        const bf16* F1 = (const bf16*)(ws + WS_F1); const bf16* F2P = (const bf16*)(ws + WS_F2P); const bf16* F2S = (const bf16*)(ws + WS_F2S);
        if (ph == 0) {
            LAS float* scr = (LAS float*)(lds + wave * 16384);
            int it = gw;
#define TRJOB(W, ldw, c0, K, ncols, gain, dst, rmode, rbase) { const int n_ = ((K) / 64) * ((ncols) / 32); for (; it < n_; it += ngw) tr_item(W, ldw, c0, K, ncols, gain, dst, rmode, rbase, scr, it, lane); it -= n_; }
            for (int l = 0; l < DEPTH; ++l) { unsigned char* wl = ws + WS_WL0 + (size_t)l * LAYER_BYTES;
                TRJOB(ap->in[3] + (size_t)l * D * DFF, DFF, 0, D, DFF, ap->in[2] + l * D, (bf16*)(wl + L_WGU1), 1, 0)
                TRJOB(ap->in[4] + (size_t)l * D * DFF, DFF, 0, D, DFF, ap->in[2] + l * D, (bf16*)(wl + L_WGU1), 1, 128)
                TRJOB(ap->in[5] + (size_t)l * DFF * D, D, 0, DFF, D, (const float*)nullptr, (bf16*)(wl + L_WD1), 0, 0)
                TRJOB(ap->in[7] + (size_t)l * D * 5120, 5120, 0, D, 2048, ap->in[6] + l * D, (bf16*)(wl + L_WIN), 0, 0)
                TRJOB(ap->in[7] + (size_t)l * D * 5120, 5120, 3072, D, 2048, ap->in[6] + l * D, (bf16*)(wl + L_WIN), 0, 4096)
                TRJOB(ap->in[11] + (size_t)l * D * D, D, 0, D, D, (const float*)nullptr, (bf16*)(wl + L_WA), 0, 0)
                TRJOB(ap->in[12] + (size_t)l * D * D, D, 0, D, D, (const float*)nullptr, (bf16*)(wl + L_WB), 0, 0)
                TRJOB(ap->in[13] + (size_t)l * D * D, D, 0, D, D, (const float*)nullptr, (bf16*)(wl + L_WO), 0, 0)
                TRJOB(ap->in[15] + (size_t)l * D * DFF, DFF, 0, D, DFF, ap->in[14] + l * D, (bf16*)(wl + L_WGU2), 1, 0)
                TRJOB(ap->in[16] + (size_t)l * D * DFF, DFF, 0, D, DFF, ap->in[14] + l * D, (bf16*)(wl + L_WGU2), 1, 128)
                TRJOB(ap->in[17] + (size_t)l * DFF * D, D, 0, DFF, D, (const float*)nullptr, (bf16*)(wl + L_WD2), 0, 0)
            }
#undef TRJOB
            __syncthreads();
            for (int item = bx; item < DEPTH * 64; item += G) { const int l = item >> 6, g = (item >> 4) & 3, kt = (item >> 1) & 7, which = item & 1;
                fold_tile(lds, ap->in[7] + (size_t)l * D * 5120, ap->in[6] + l * D, (bf16*)(ws + WS_WL0 + (size_t)l * LAYER_BYTES + L_WIN), g, kt, which, tidv); }
            { const int gt = bx * NTHR + tid, ngt = G * NTHR;
              for (int i = gt; i < DEPTH * 8 * 128 * 128; i += ngt) { const int l = i >> 17, r = i & 131071; ((bf16*)(ws + WS_WL0 + (size_t)l * LAYER_BYTES + L_WS))[r] = (bf16)f2bf(ap->in[9][i]); }
              for (int i = gt; i < 256 * 256; i += ngt) { const int r = i >> 8, c = i & 255, m = ((r & 127) * (c & 127)) & 127; float sn, cs; sincospif((float)m * (1.0f / 64.0f), &sn, &cs);
                  const float sc = 0.08838834764831845f; float v = (r < 128) ? ((c < 128) ? cs : -sn) : ((c < 128) ? sn : cs); ((bf16*)(ws + WS_F1))[i] = (bf16)f2bf(v * sc); }
              for (int i = gt; i < 128 * 256; i += ngt) { const int r = i >> 8, c = i & 255, m = (r * (c & 127)) & 127; float sn, cs; sincospif((float)m * (1.0f / 64.0f), &sn, &cs);
                  ((bf16*)(ws + WS_F2P))[i] = (bf16)f2bf(((c < 128) ? cs : -sn) * 0.08838834764831845f); }
              for (int i = gt; i < 128 * 256; i += ngt) { const int o = i >> 8, c = i & 255, ii = c & 127, m = ((o & 31) * (ii & 31)) & 31; float sn, cs; sincospif((float)m * (1.0f / 16.0f), &sn, &cs);
                  const float v = ((o >> 5) == (ii >> 5)) ? ((c < 128) ? cs : -sn) * 0.17677669529663687f : 0.f; ((bf16*)(ws + WS_F2S))[i] = (bf16)f2bf(v); } }
            x0_rows(ap->in[0], XB, (float*)(ws + WS_SSP), gw, ngw, lane);
        } else {
            const int q = ph - 1, pass = q / PASS_PH, s = q % PASS_PH;
            float* SSP = (float*)(ws + WS_SSP) + (size_t)pass * MP * 16;
            float* X = ap->out + (size_t)pass * MP * D;
            if (s == PASS_PH - 1) {
                final_rows(X, XB, SSP, ap->in[18], gw, ngw, lane);
                if (pass + 1 < NPASS) x0_rows(ap->in[pass + 1], XB, (float*)(ws + WS_SSP) + (size_t)(pass + 1) * MP * 16, gw, ngw, lane);
            } else {
                const int l = s / STEPS, step = s % STEPS;
                unsigned char* wl = ws + WS_WL0 + (size_t)l * LAYER_BYTES;
                const int S = pass == 0 ? 16384 : 4096, N2 = S / 128;
                switch (step) {
                case 0: case 8: {
                    pg8::Gemm g{XB, (const bf16*)(wl + (step == 0 ? L_WGU1 : L_WGU2)), MP, 2 * DFF, D}; pg8::StaticOrder so; so.init(MP, 2 * DFF, G, bx);
                    pg8::EpiSwiGLU E{Hb, SSP, DFF};
                    pg8::gemm_phase<pg8::EpiSwiGLU, pg8::StaticOrder, true, true>(lds, g, so, E, tidv);
                } break;
                case 1: case 9: {
                    pg8::Gemm g{Hb, (const bf16*)(wl + (step == 1 ? L_WD1 : L_WD2)), MP, D, DFF}; pg8::StaticOrder so; so.init(MP, D, G, bx);
                    pg8::EpiResid E{XB, SSP, 0.5f};
                    pg8::gemm_phase<pg8::EpiResid, pg8::StaticOrder, true, true>(lds, g, so, E, tidv);
                } break;
                case 2: {
                    pg8::Gemm g{XB, (const bf16*)(wl + L_WIN), MP, 6144, D}; pg8::StaticOrder so; so.init(MP, 6144, G, bx);
                    pg8::EpiW1 E{Ub, GAb, (size_t)MP * D, SSP, SSV};
                    pg8::gemm_phase<pg8::EpiW1, pg8::StaticOrder, true, true>(lds, g, so, E, tidv);
                } break;
                case 3: {
                    for (int t = bx; t < 4096; t += G) {
                        if (t < 2048) { const int ct = t & 7, rest = t >> 3, n2 = rest % N2, sq = rest / N2; const size_t o = ((size_t)sq * S + n2) * D + ct * 128;
                            F1RP rp{Pb + o, Qb + o, N2}; F1EP ep{Pb + o, Qb + o, N2, n2, 2.0f / (float)S};
                            smm_tile<2, 256>(lds, F1, rp, XfNone{}, ep, tidv);
                        } else { const int tt = t - 2048, h = tt & 7, c = tt >> 3; const size_t o = (size_t)c * 128 * D + h * 128;
                            SguRP rp{Vb + o}; SguXF xf{SSV + (size_t)c * 128 * 16, ap->in[8] + l * D + h * 128}; SguEP ep{Ub + o, ap->in[10] + (l * 8 + h) * 128};
                            smm_tile<1, 128>(lds, (const bf16*)(wl + L_WS) + (size_t)h * 128 * 128, rp, xf, ep, tidv); } }
                } break;
                case 4: {
                    const int nblk = S / 128;
                    for (int t = bx; t < 2048; t += G) { const int ct = t & 7, rest = t >> 3, blk = rest % nblk, sq = rest / nblk; const size_t o = ((size_t)sq * S + (size_t)blk * 128) * D + ct * 128;
                        F2RP rp{Pb + o, Qb + o}; F2EP ep{Vb + (size_t)sq * S * D + ct * 128, blk, pass};
                        smm_tile<1, 256>(lds, pass ? F2S : F2P, rp, XfNone{}, ep, tidv); }
                } break;
                case 5: {
                    pg8::Gemm g{Ub, (const bf16*)(wl + L_WA), MP, D, D}; pg8::StaticOrder so; so.init(MP, D, G, bx);
                    pg8::EpiMerge<0> E{GAb, GBb};
                    pg8::gemm_phase<pg8::EpiMerge<0>, pg8::StaticOrder, true, true>(lds, g, so, E, tidv);
                } break;
                case 6: {
                    pg8::Gemm g{Vb, (const bf16*)(wl + L_WB), MP, D, D}; pg8::StaticOrder so; so.init(MP, D, G, bx);
                    pg8::EpiMerge<1> E{GAb, GBb};
                    pg8::gemm_phase<pg8::EpiMerge<1>, pg8::StaticOrder, true, true>(lds, g, so, E, tidv);
                } break;
                case 7: {
                    pg8::Gemm g{GAb, (const bf16*)(wl + L_WO), MP, D, D}; pg8::StaticOrder so; so.init(MP, D, G, bx);
                    pg8::EpiResid E{XB, SSP, 1.0f};
                    pg8::gemm_phase<pg8::EpiResid, pg8::StaticOrder, true, true>(lds, g, so, E, tidv);
                } break;
                }
            }
        }
        if (ph + 1 < ph_hi) {
            if (ph_hi > 1000000) { __syncthreads(); cg::this_grid().sync(); }
            else if (ph > 0 && ((ph - 1) % PASS_PH) != PASS_PH - 1 && (((ph - 1) % PASS_PH) % STEPS) == 4) { __syncthreads(); }
            else { XcdBarrier xb; xb.bar = (unsigned*)ws; xb.x = xb_xcc_id(); xb.st = (volatile LAS unsigned*)(lds + XB_LDS_OFF); xcd_barrier(xb); }
        }
    }
}

extern "C" void kernel_launch(void* const* d_in, const int* in_sizes, int n_in, void* d_out, int out_size, void* d_ws, size_t ws_size, hipStream_t stream) {
    static int grid = 0;
    if (grid == 0) {
        if (n_in != 19 || out_size != NPASS * MP * D || ws_size < WS_END) { fprintf(stderr, "kernel_launch: unexpected shapes (n_in %d, out %d, ws %zu < %zu)\n", n_in, out_size, ws_size, (size_t)WS_END); grid = -1; return; }
        int dev = 0, cus = 0, per_cu = 0;
        hipGetDevice(&dev); hipDeviceGetAttribute(&cus, hipDeviceAttributeMultiprocessorCount, dev);
        if (hipFuncSetAttribute((const void*)mk_fwd, hipFuncAttributeMaxDynamicSharedMemorySize, LDS_BYTES) != hipSuccess) { fprintf(stderr, "kernel_launch: hipFuncSetAttribute failed\n"); grid = -1; return; }
        if (hipOccupancyMaxActiveBlocksPerMultiprocessor(&per_cu, (const void*)mk_fwd, NTHR, LDS_BYTES) != hipSuccess || per_cu < 1) { fprintf(stderr, "kernel_launch: occupancy query says %d\n", per_cu); per_cu = 1; }
        (void)hipGetLastError();
        grid = cus * 1;
    }
    if (grid < 0) return;
    if (hipMemsetAsync(d_ws, 0, 16384, stream) != hipSuccess) { fprintf(stderr, "kernel_launch: memset of the barrier words failed\n"); return; }
    Args a{};
    for (int i = 0; i < 19; ++i) a.in[i] = (const float*)d_in[i];
    a.out = (float*)d_out; a.ws = (unsigned char*)d_ws;
#if MK_PER_PHASE
    for (int ph = 0; ph < NPHASE; ++ph) { a.ph_lo = ph; a.ph_hi = ph + 1; hipLaunchKernelGGL(mk_fwd, dim3(grid), dim3(NTHR), LDS_BYTES, stream, a); }
#else
    a.ph_lo = 0; a.ph_hi = NPHASE;
    void* kargs[] = {&a};
    hipError_t e = hipLaunchCooperativeKernel((const void*)mk_fwd, dim3(grid), dim3(NTHR), kargs, LDS_BYTES, stream);
    if (e != hipSuccess) fprintf(stderr, "kernel_launch: cooperative launch failed: %s (grid %d)\n", hipGetErrorString(e), grid);
#endif
}
```

```cpp
#include <hip/hip_runtime.h>
#include <hip/hip_cooperative_groups.h>
#include <cstdio>
#include <cstdint>
namespace cg = cooperative_groups;
namespace pg8 {
#define PG8_LAS __attribute__((address_space(3)))
typedef unsigned short bf16_t;
typedef short bf16x8 __attribute__((ext_vector_type(8)));
typedef float f32x4 __attribute__((ext_vector_type(4)));
typedef unsigned u32x4 __attribute__((ext_vector_type(4)));
constexpr int BM = 256, BK = 64, HALF = 128, HTB = HALF * BK * 2  , STAGE_BYTES = 8 * HTB, NXCD = 8, WGM = 8;

__host__ __device__ __forceinline__ int lds_byte(int r, int c) { const int st = (r >> 4) * 2 + (c >> 5), rr = r & 15, cc = c & 31, ob = rr * 64 + cc * 2; return st * 1024 + (ob ^ (((ob >> 9) & 1) << 5)); }
__host__ __device__ __forceinline__ void stage_rc(int b, int& R, int& C) { const int st = b / 1024, sb = b % 1024, swz = sb ^ (((sb >> 9) & 1) << 5); R = (st >> 1) * 16 + swz / 64; C = (st & 1) * 32 + (swz % 64) / 2; }
__host__ __device__ __forceinline__ int perm32(int rho) { const int n = rho >> 4, i = rho & 15; return 8 * (i >> 2) + 4 * n + (i & 3); }

struct Unit { int pm, pn; };
struct Gemm { const bf16_t* A; const bf16_t* Bt; int M, N, K; };

struct StaticOrder {
    int nM, nN, nwg, G, c;
    __host__ __device__ void init(int M, int N, int G_, int c_) { nM = M / BM; nN = N / BM; nwg = nM * nN; G = G_; c = c_; }
    __host__ __device__ bool next(int i, Unit& u) const {
        const long L = (long)i * G + c; if (L >= nwg) return false;
        int wgid = (int)L; { const int q = nwg / NXCD, r = nwg % NXCD, xcd = wgid % NXCD, off = wgid / NXCD; wgid = (xcd < r ? xcd * (q + 1) : r * (q + 1) + (xcd - r) * q) + off; }
        const int nig = WGM * nN, gid = wgid / nig, fm = gid * WGM, gsz = (nM - fm) < WGM ? (nM - fm) : WGM;
        u.pm = fm + ((wgid % nig) % gsz); u.pn = (wgid % nig) / gsz; return true;
    }
    __device__ __forceinline__ void a_ready(const Unit&) const {}
    __device__ __forceinline__ void done(const Unit&) const {}
};

typedef __bf16 bf16x2_t __attribute__((ext_vector_type(2)));
__device__ __forceinline__ unsigned cvt_pk_bf16(float lo, float hi) { typedef float f32x2_ __attribute__((ext_vector_type(2))); const bf16x2_t r = __builtin_convertvector((f32x2_){lo, hi}, bf16x2_t); return __builtin_bit_cast(unsigned, r); }
typedef float f32x2 __attribute__((ext_vector_type(2)));
__device__ __forceinline__ f32x2 gelu_pk(f32x2 v) {
    const f32x2 av = __builtin_elementwise_abs(v), d = av * 0.2316418882f + 1.0f;
    f32x2 t; t.x = __builtin_amdgcn_rcpf(d.x); t.y = __builtin_amdgcn_rcpf(d.y);
    f32x2 q = t * 0.5307027145f + (-0.7265760135f); q = q * t + 0.7107068705f; q = q * t + (-0.142248368f); q = q * t + 0.127414796f; q = q * t;
    const f32x2 s = (v * v) * (-0.72134752044f);
    f32x2 e; e.x = __builtin_amdgcn_exp2f(s.x); e.y = __builtin_amdgcn_exp2f(s.y);
    const f32x2 qe = q * e; f32x2 o; o.x = __builtin_fmaf(-av.x, qe.x, __builtin_fmaxf(v.x, 0.f)); o.y = __builtin_fmaf(-av.y, qe.y, __builtin_fmaxf(v.y, 0.f)); return o;
}

typedef unsigned u32x2 __attribute__((ext_vector_type(2)));
__device__ __forceinline__ float bf_lo(unsigned w) { return __builtin_bit_cast(float, w << 16); }
__device__ __forceinline__ float bf_hi(unsigned w) { return __builtin_bit_cast(float, w & 0xffff0000u); }
__device__ __forceinline__ float row_rscale(const float* ssp, int row, int fq) {
    const f32x4 v = *(const f32x4*)(ssp + (size_t)row * 16 + fq * 4);
    float s = (v[0] + v[1]) + (v[2] + v[3]);
    s += __shfl_xor(s, 16); s += __shfl_xor(s, 32);
    return __builtin_amdgcn_rsqf(s * (1.0f / 1024.0f) + 1e-6f);
}
__device__ __forceinline__ float sigmoid_f(float x) { return __builtin_amdgcn_rcpf(1.0f + __builtin_amdgcn_exp2f(x * -1.44269504089f)); }

__device__ __forceinline__ void row_rscales(const float* ssp, int row0, int fq, float (&r)[2][4], float (&ms)[2][4]) {
    f32x4 sv[2][4];
#pragma unroll
    for (int ai = 0; ai < 2; ++ai)
#pragma unroll
        for (int m = 0; m < 4; ++m) sv[ai][m] = *(const f32x4*)(ssp + (size_t)(row0 + ai * HALF + m * 16) * 16 + fq * 4);
#pragma unroll
    for (int ai = 0; ai < 2; ++ai)
#pragma unroll
        for (int m = 0; m < 4; ++m) { const f32x4 v = sv[ai][m]; float s = (v[0] + v[1]) + (v[2] + v[3]); s += __shfl_xor(s, 16); s += __shfl_xor(s, 32);
            ms[ai][m] = s * (1.0f / 1024.0f) + 1e-6f; r[ai][m] = __builtin_amdgcn_rsqf(ms[ai][m]); }
}
__device__ __forceinline__ void row_rscales(const float* ssp, int row0, int fq, float (&r)[2][4]) { float ms[2][4]; row_rscales(ssp, row0, fq, r, ms); }
struct EpiSwiGLU {
    static constexpr bool PERM = true, AFTER_DRAIN = false;
    bf16_t* H; const float* ssp; int ldh;
    __device__ __forceinline__ void operator()(const f32x4 (&acc)[2][2][4][2], const Unit& u, int wr, int wc, int fr, int fq) const {
        const int row0 = u.pm * BM + wr * 64 + fr, col0 = u.pn * HALF + wc * 32 + 8 * fq;
        float rs[2][4], msq[2][4]; row_rscales(ssp, row0, fq, rs, msq);
#pragma unroll
        for (int ai = 0; ai < 2; ++ai)
#pragma unroll
            for (int m = 0; m < 4; ++m) { const int row = row0 + ai * HALF + m * 16; const float r = rs[ai][m], mq = msq[ai][m];
                unsigned w[4];
                const float rc = r * -1.44269504089f;
#pragma unroll
                for (int n = 0; n < 2; ++n) { const f32x4 ga = acc[ai][0][m][n], gu = ga * acc[ai][1][m][n], ex = ga * rc; float h[4];
#pragma unroll
                    for (int j = 0; j < 4; ++j) h[j] = gu[j] * __builtin_amdgcn_rcpf(__builtin_fmaf(__builtin_amdgcn_exp2f(ex[j]), mq, mq));
                    w[2 * n] = cvt_pk_bf16(h[0], h[1]); w[2 * n + 1] = cvt_pk_bf16(h[2], h[3]); }
                u32x4 o; o.x = w[0]; o.y = w[1]; o.z = w[2]; o.w = w[3];
                *(u32x4*)(H + (size_t)row * ldh + col0) = o; }
    }
};
struct EpiResid {
    static constexpr bool PERM = true, AFTER_DRAIN = false;
    bf16_t* xb; float* ssp; float scale;
    __device__ __forceinline__ void operator()(const f32x4 (&acc)[2][2][4][2], const Unit& u, int wr, int wc, int fr, int fq) const {
        const int row0 = u.pm * BM + wr * 64 + fr, col0 = u.pn * BM + wc * 32 + 8 * fq;
#pragma unroll
        for (int ai = 0; ai < 2; ++ai) {
            u32x4 a[4][2];
#pragma unroll
            for (int m = 0; m < 4; ++m)
#pragma unroll
                for (int bj = 0; bj < 2; ++bj) a[m][bj] = *(const u32x4*)(xb + (size_t)(row0 + ai * HALF + m * 16) * 1024 + col0 + bj * HALF);
#pragma unroll
            for (int m = 0; m < 4; ++m) { const int row = row0 + ai * HALF + m * 16; float ss = 0.f;
#pragma unroll
                for (int bj = 0; bj < 2; ++bj) { const f32x4 v0 = acc[ai][bj][m][0] * scale, v1 = acc[ai][bj][m][1] * scale; const u32x4 x = a[m][bj];
                    const f32x4 o0 = (f32x4){bf_lo(x.x) + v0[0], bf_hi(x.x) + v0[1], bf_lo(x.y) + v0[2], bf_hi(x.y) + v0[3]};
                    const f32x4 o1 = (f32x4){bf_lo(x.z) + v1[0], bf_hi(x.z) + v1[1], bf_lo(x.w) + v1[2], bf_hi(x.w) + v1[3]};
                    ss += (o0[0] * o0[0] + o0[1] * o0[1]) + (o0[2] * o0[2] + o0[3] * o0[3]) + (o1[0] * o1[0] + o1[1] * o1[1]) + (o1[2] * o1[2] + o1[3] * o1[3]);
                    u32x4 w; w.x = cvt_pk_bf16(o0[0], o0[1]); w.y = cvt_pk_bf16(o0[2], o0[3]); w.z = cvt_pk_bf16(o1[0], o1[1]); w.w = cvt_pk_bf16(o1[2], o1[3]);
                    *(u32x4*)(xb + (size_t)row * 1024 + col0 + bj * HALF) = w; }
                ss += __shfl_xor(ss, 16); ss += __shfl_xor(ss, 32);
                if (fq == 0) ssp[(size_t)row * 16 + u.pn * 4 + wc] = ss; }
            asm volatile("" ::: "memory"); }
    }
};
struct EpiW1 {
    static constexpr bool PERM = true, AFTER_DRAIN = false;
    bf16_t* dst0; bf16_t* dst1; size_t gstride; const float* ssp; float* ssv;
    __device__ __forceinline__ void operator()(const f32x4 (&acc)[2][2][4][2], const Unit& u, int wr, int wc, int fr, int fq) const {
        const int grp = u.pn >> 2, row0 = u.pm * BM + wr * 64 + fr, col0 = (u.pn & 3) * BM + wc * 32 + 8 * fq;
        bf16_t* dst = grp < 4 ? dst0 + (size_t)grp * gstride : dst1 + (size_t)(grp - 4) * gstride;
        float rs[2][4]; row_rscales(ssp, row0, fq, rs);
#pragma unroll
        for (int ai = 0; ai < 2; ++ai)
#pragma unroll
            for (int m = 0; m < 4; ++m) { const int row = row0 + ai * HALF + m * 16; const float r = rs[ai][m]; float ss = 0.f;
#pragma unroll
                for (int bj = 0; bj < 2; ++bj) { f32x4 v0 = acc[ai][bj][m][0] * r, v1 = acc[ai][bj][m][1] * r;
                    if (grp < 2) { const f32x2 a = gelu_pk((f32x2){v0[0], v0[1]}), b = gelu_pk((f32x2){v0[2], v0[3]}), c = gelu_pk((f32x2){v1[0], v1[1]}), d = gelu_pk((f32x2){v1[2], v1[3]});
                        v0 = (f32x4){a.x, a.y, b.x, b.y}; v1 = (f32x4){c.x, c.y, d.x, d.y};
                        ss += (v0[0] * v0[0] + v0[1] * v0[1]) + (v0[2] * v0[2] + v0[3] * v0[3]) + (v1[0] * v1[0] + v1[1] * v1[1]) + (v1[2] * v1[2] + v1[3] * v1[3]); }
                    else if (grp >= 4) { const float rc = r * -1.44269504089f; const f32x4 e0 = acc[ai][bj][m][0] * rc, e1 = acc[ai][bj][m][1] * rc;
#pragma unroll
                        for (int j = 0; j < 4; ++j) { v0[j] = __builtin_amdgcn_rcpf(1.0f + __builtin_amdgcn_exp2f(e0[j])); v1[j] = __builtin_amdgcn_rcpf(1.0f + __builtin_amdgcn_exp2f(e1[j])); } }
                    u32x4 w; w.x = cvt_pk_bf16(v0[0], v0[1]); w.y = cvt_pk_bf16(v0[2], v0[3]); w.z = cvt_pk_bf16(v1[0], v1[1]); w.w = cvt_pk_bf16(v1[2], v1[3]);
                    *(u32x4*)(dst + (size_t)row * 1024 + col0 + bj * HALF) = w; }
                if (grp == 1) { ss += __shfl_xor(ss, 16); ss += __shfl_xor(ss, 32); if (fq == 0) ssv[(size_t)row * 16 + (u.pn & 3) * 4 + wc] = ss; } }
    }
};
template <int MODE> struct EpiMerge {
    static constexpr bool PERM = true, AFTER_DRAIN = false;
    bf16_t* io; const bf16_t* gb;
    __device__ __forceinline__ void operator()(const f32x4 (&acc)[2][2][4][2], const Unit& u, int wr, int wc, int fr, int fq) const {
        const int row0 = u.pm * BM + wr * 64 + fr, col0 = u.pn * BM + wc * 32 + 8 * fq;
        constexpr int MB_ = (MODE == 0) ? 4 : 2;
#pragma unroll
        for (int ai = 0; ai < 2; ++ai)
#pragma unroll
            for (int m0 = 0; m0 < 4; m0 += MB_) {
                u32x4 a[MB_][2], g[MB_][2];
#pragma unroll
                for (int mm = 0; mm < MB_; ++mm)
#pragma unroll
                    for (int bj = 0; bj < 2; ++bj) { const size_t off = (size_t)(row0 + ai * HALF + (m0 + mm) * 16) * 1024 + col0 + bj * HALF;
                        a[mm][bj] = *(const u32x4*)(io + off); if (MODE == 1) g[mm][bj] = *(const u32x4*)(gb + off); }
#pragma unroll
                for (int mm = 0; mm < MB_; ++mm)
#pragma unroll
                    for (int bj = 0; bj < 2; ++bj) { const int m = m0 + mm; const size_t off = (size_t)(row0 + ai * HALF + m * 16) * 1024 + col0 + bj * HALF;
                        const u32x4 x = a[mm][bj]; const f32x4 v0 = acc[ai][bj][m][0], v1 = acc[ai][bj][m][1]; f32x4 o0, o1;
                        if (MODE == 0) { o0 = (f32x4){bf_lo(x.x) * v0[0], bf_hi(x.x) * v0[1], bf_lo(x.y) * v0[2], bf_hi(x.y) * v0[3]}; o1 = (f32x4){bf_lo(x.z) * v1[0], bf_hi(x.z) * v1[1], bf_lo(x.w) * v1[2], bf_hi(x.w) * v1[3]}; }
                        else { const u32x4 y = g[mm][bj];
                            o0 = (f32x4){bf_lo(x.x) + bf_lo(y.x) * v0[0], bf_hi(x.x) + bf_hi(y.x) * v0[1], bf_lo(x.y) + bf_lo(y.y) * v0[2], bf_hi(x.y) + bf_hi(y.y) * v0[3]};
                            o1 = (f32x4){bf_lo(x.z) + bf_lo(y.z) * v1[0], bf_hi(x.z) + bf_hi(y.z) * v1[1], bf_lo(x.w) + bf_lo(y.w) * v1[2], bf_hi(x.w) + bf_hi(y.w) * v1[3]}; }
                        u32x4 w; w.x = cvt_pk_bf16(o0[0], o0[1]); w.y = cvt_pk_bf16(o0[2], o0[3]); w.z = cvt_pk_bf16(o1[0], o1[1]); w.w = cvt_pk_bf16(o1[2], o1[3]);
                        *(u32x4*)(io + off) = w; }
                asm volatile("" ::: "memory"); }
    }
};

template <class Epi, class Sched, bool ALIGN_EPI = false, bool SP2 = false>
__device__ __forceinline__ void gemm_phase(PG8_LAS unsigned char* lds, const Gemm g, const Sched& S, const Epi& E, const int tid_in) {
    const int tid = tid_in, wid = __builtin_amdgcn_readfirstlane(tid >> 6), lane = tid & 63, wr = wid >> 2, wc = wid & 3, fr = lane & 15, fq = lane >> 4;
    const int K = g.K, nt = K / BK;
    unsigned voffA[2], voffB[2];
#pragma unroll
    for (int i = 0; i < 2; ++i) { int R, C; stage_rc(tid * 16 + i * 8192, R, C); const int Rb = Epi::PERM ? ((R & ~31) + perm32(R & 31)) : R;
        voffA[i] = (unsigned)(R * K + C) * 2u; voffB[i] = (unsigned)(Rb * K + C) * 2u; }
    const size_t kstep = (size_t)(BK * 2);
    const size_t hstep = (size_t)HALF * K * 2;
    const size_t tstep = 2 * hstep;
    const unsigned ldsw = (unsigned)wid * 1024u;
    const int aoff = lds_byte(wr * 64 + fr, fq * 8), boff = lds_byte(wc * 32 + fr, fq * 8);
#define PG8_SA(b, h) (((b) * 2 + (h)) * HTB)
#define PG8_SB(b, h) ((4 + (b) * 2 + (h)) * HTB)
#define PG8_STAGE(bufoff, gbase, voff) do { _Pragma("unroll") for (int _i = 0; _i < 2; ++_i) \
        __builtin_amdgcn_global_load_lds((const unsigned*)((const char*)(gbase) + (voff)[_i]), (PG8_LAS unsigned*)(lds + (bufoff) + ldsw + _i * 8192), 16, 0, 0); } while (0)
#define PG8_LDA(dst, b, h) do { _Pragma("unroll") for (int m = 0; m < 4; ++m) _Pragma("unroll") for (int k = 0; k < 2; ++k) dst[m][k] = *(const PG8_LAS bf16x8*)(lds + PG8_SA(b, h) + aoff + m * 2048 + k * 1024); } while (0)
#define PG8_LDB(dst, b, h) do { _Pragma("unroll") for (int n = 0; n < 2; ++n) _Pragma("unroll") for (int k = 0; k < 2; ++k) dst[n][k] = *(const PG8_LAS bf16x8*)(lds + PG8_SB(b, h) + boff + n * 2048 + k * 1024); } while (0)
#define PG8_MMA(ai, bj, At, Bt) do { __builtin_amdgcn_s_setprio(1); _Pragma("unroll") for (int m = 0; m < 4; ++m) _Pragma("unroll") for (int n = 0; n < 2; ++n) _Pragma("unroll") for (int k = 0; k < 2; ++k) \
        acc[ai][bj][m][n] = __builtin_amdgcn_mfma_f32_16x16x32_bf16(Bt[n][k], At[m][k], acc[ai][bj][m][n], 0, 0, 0); __builtin_amdgcn_s_setprio(0); } while (0)
#define PG8_WAIT_V(n) asm volatile("s_waitcnt vmcnt(" #n ")" ::: "memory")
#define PG8_WAIT_L(n) asm volatile("s_waitcnt lgkmcnt(" #n ")" ::: "memory")
#define PG8_BAR __builtin_amdgcn_s_barrier()
#define PG8_SCHED __builtin_amdgcn_sched_barrier(0)
    Unit cur, nxt; int ui = 0;
    if (!S.next(0, cur)) return;
    f32x4 acc[2][2][4][2];
#pragma unroll
    for (int a = 0; a < 2; ++a)
#pragma unroll
        for (int b = 0; b < 2; ++b)
#pragma unroll
            for (int m = 0; m < 4; ++m)
#pragma unroll
                for (int n = 0; n < 2; ++n) acc[a][b][m][n] = (f32x4){0.f, 0.f, 0.f, 0.f};
    bf16x8 At[4][2], B0[2][2], B1[2][2];
    const char* cA = (const char*)g.A + (size_t)cur.pm * tstep; const char* cB = (const char*)g.Bt + (size_t)cur.pn * tstep;
    S.a_ready(cur);
    if constexpr (SP2) {
        PG8_STAGE(PG8_SB(0, 0), cB, voffB); PG8_STAGE(PG8_SB(0, 1), cB + hstep, voffB); PG8_STAGE(PG8_SA(0, 0), cA, voffA); PG8_STAGE(PG8_SA(0, 1), cA + hstep, voffA);
        PG8_STAGE(PG8_SB(1, 0), cB + kstep, voffB); PG8_STAGE(PG8_SA(1, 0), cA + kstep, voffA); PG8_STAGE(PG8_SB(1, 1), cB + hstep + kstep, voffB);
        if (wr == 1) PG8_BAR;
        PG8_WAIT_V(8); PG8_BAR;
        PG8_WAIT_V(6); PG8_BAR;
    } else {
        PG8_STAGE(PG8_SB(0, 0), cB, voffB); PG8_STAGE(PG8_SA(0, 0), cA, voffA); PG8_STAGE(PG8_SB(0, 1), cB + hstep, voffB); PG8_STAGE(PG8_SA(0, 1), cA + hstep, voffA);
        if (wr == 1) PG8_BAR;
        PG8_WAIT_V(4); PG8_BAR;
        PG8_STAGE(PG8_SB(1, 0), cB + kstep, voffB); PG8_STAGE(PG8_SA(1, 0), cA + kstep, voffA); PG8_STAGE(PG8_SB(1, 1), cB + hstep + kstep, voffB);
        PG8_WAIT_V(6); PG8_BAR;
    }
    for (;;) {
        const bool has_next = S.next(ui + 1, nxt);
        const char* nA = has_next ? (const char*)g.A + (size_t)nxt.pm * tstep : cA; const char* nB = has_next ? (const char*)g.Bt + (size_t)nxt.pn * tstep : cB;
        for (int t = 0; t < nt; t += 2) {
            const bool last = (t == nt - 2);
            const char* a1 = cA + (size_t)(t + 1) * kstep;
            const char* a2 = last ? nA : cA + (size_t)(t + 2) * kstep; const char* b2 = last ? nB : cB + (size_t)(t + 2) * kstep;
            const char* a3 = a2 + kstep; const char* b3 = b2 + kstep;
            if (last && has_next) S.a_ready(nxt);
            if constexpr (SP2) {
            PG8_LDB(B0, 0, 0); PG8_LDB(B1, 0, 1); PG8_SCHED; PG8_LDA(At, 0, 0); PG8_STAGE(PG8_SA(1, 1), a1 + hstep, voffA);
            PG8_WAIT_V(8); PG8_WAIT_L(0); PG8_BAR; PG8_MMA(0, 0, At, B0); PG8_MMA(0, 1, At, B1); PG8_BAR; PG8_SCHED;
            PG8_LDA(At, 0, 1); PG8_STAGE(PG8_SB(0, 0), b2, voffB); PG8_STAGE(PG8_SB(0, 1), b2 + hstep, voffB); PG8_STAGE(PG8_SA(0, 0), a2, voffA);
            PG8_WAIT_V(8); PG8_WAIT_L(0); PG8_BAR; PG8_MMA(1, 0, At, B0); PG8_MMA(1, 1, At, B1); PG8_BAR; PG8_SCHED;
            PG8_LDB(B0, 1, 0); PG8_LDB(B1, 1, 1); PG8_SCHED; PG8_LDA(At, 1, 0); PG8_STAGE(PG8_SA(0, 1), a2 + hstep, voffA);
            PG8_WAIT_V(8); PG8_WAIT_L(0); PG8_BAR; PG8_MMA(0, 0, At, B0); PG8_MMA(0, 1, At, B1); PG8_BAR; PG8_SCHED;
            PG8_LDA(At, 1, 1); PG8_STAGE(PG8_SB(1, 0), b3, voffB); PG8_STAGE(PG8_SB(1, 1), b3 + hstep, voffB); PG8_STAGE(PG8_SA(1, 0), a3, voffA);
            PG8_WAIT_V(8); PG8_WAIT_L(0); PG8_BAR; PG8_MMA(1, 0, At, B0); PG8_MMA(1, 1, At, B1); PG8_BAR; PG8_SCHED;
            } else {
            PG8_LDB(B0, 0, 0); PG8_SCHED; PG8_LDA(At, 0, 0); PG8_STAGE(PG8_SA(1, 1), a1 + hstep, voffA);
            PG8_WAIT_L(8); PG8_BAR; PG8_WAIT_L(0); PG8_MMA(0, 0, At, B0); PG8_BAR; PG8_SCHED;
            PG8_LDB(B1, 0, 1); PG8_STAGE(PG8_SB(0, 0), b2, voffB);
            PG8_BAR; PG8_WAIT_L(0); PG8_MMA(0, 1, At, B1); PG8_BAR;
            PG8_LDA(At, 0, 1); PG8_STAGE(PG8_SA(0, 0), a2, voffA);
            PG8_BAR; PG8_WAIT_L(0); PG8_MMA(1, 0, At, B0); PG8_BAR; PG8_SCHED;
            PG8_STAGE(PG8_SB(0, 1), b2 + hstep, voffB);
            PG8_WAIT_V(6); PG8_BAR; PG8_MMA(1, 1, At, B1); PG8_BAR;
            PG8_LDB(B0, 1, 0); PG8_SCHED; PG8_LDA(At, 1, 0); PG8_STAGE(PG8_SA(0, 1), a2 + hstep, voffA);
            PG8_WAIT_L(8); PG8_BAR; PG8_WAIT_L(0); PG8_MMA(0, 0, At, B0); PG8_BAR; PG8_SCHED;
            PG8_LDB(B1, 1, 1); PG8_STAGE(PG8_SB(1, 0), b3, voffB);
            PG8_BAR; PG8_WAIT_L(0); PG8_MMA(0, 1, At, B1); PG8_BAR;
            PG8_LDA(At, 1, 1); PG8_STAGE(PG8_SA(1, 0), a3, voffA);
            PG8_BAR; PG8_WAIT_L(0); PG8_MMA(1, 0, At, B0); PG8_BAR; PG8_SCHED;
            PG8_STAGE(PG8_SB(1, 1), b3 + hstep, voffB);
            PG8_WAIT_V(6); PG8_BAR; PG8_MMA(1, 1, At, B1); PG8_BAR;
            }
        }
        if constexpr (ALIGN_EPI) { if (wr == 0) PG8_BAR; }
        if constexpr (!Epi::AFTER_DRAIN) { E(acc, cur, wr, wc, fr, fq); S.done(cur); }
        if (!has_next) break;
#pragma unroll
        for (int a = 0; a < 2; ++a)
#pragma unroll
            for (int b = 0; b < 2; ++b)
#pragma unroll
                for (int m = 0; m < 4; ++m)
#pragma unroll
                    for (int n = 0; n < 2; ++n) acc[a][b][m][n] = (f32x4){0.f, 0.f, 0.f, 0.f};
        cur = nxt; cA = nA; cB = nB; ++ui;
        if constexpr (ALIGN_EPI) { if (wr == 1) PG8_BAR; }
    }
    PG8_WAIT_V(0);
    if constexpr (!ALIGN_EPI) { if (wr == 0) PG8_BAR; }
    PG8_BAR;
    if constexpr (Epi::AFTER_DRAIN) { E.fused(acc, cur, wr, wc, fr, fq, lds, wid, lane); S.done(cur); }
#undef PG8_SA
#undef PG8_SB
#undef PG8_STAGE
#undef PG8_LDA
#undef PG8_LDB
#undef PG8_MMA
#undef PG8_WAIT_V
#undef PG8_WAIT_L
#undef PG8_BAR
#undef PG8_SCHED
}
}

#ifndef MK_PER_PHASE
#define MK_PER_PHASE 0
#endif
#define LAS __attribute__((address_space(3)))
typedef unsigned short bf16;
typedef unsigned v4u __attribute__((ext_vector_type(4)));
typedef unsigned v2u __attribute__((ext_vector_type(2)));
typedef float f32x4 __attribute__((ext_vector_type(4)));
typedef short bf16x8 __attribute__((ext_vector_type(8)));
typedef short s16x4 __attribute__((ext_vector_type(4)));
#define LDS_WAIT() asm volatile("s_waitcnt lgkmcnt(0)" ::: "memory")

constexpr int D = 1024, DFF = 2816, MP = 32768  , NPASS = 2, DEPTH = 2;
constexpr int NWAVES = 8, NTHR = 512;
constexpr float EPS = 1e-6f;
constexpr size_t WS_F1 = 65536, WS_F2P = WS_F1 + 131072, WS_F2S = WS_F2P + 65536;
constexpr size_t WS_WL0 = 1048576;
constexpr size_t L_WGU1 = 0, L_WD1 = L_WGU1 + (size_t)2 * DFF * D * 2, L_WIN = L_WD1 + (size_t)D * DFF * 2, L_WA = L_WIN + (size_t)6144 * D * 2,
                 L_WB = L_WA + (size_t)D * D * 2, L_WO = L_WB + (size_t)D * D * 2, L_WGU2 = L_WO + (size_t)D * D * 2, L_WD2 = L_WGU2 + (size_t)2 * DFF * D * 2,
                 L_WS = L_WD2 + (size_t)D * DFF * 2, LAYER_BYTES = L_WS + (size_t)8 * 128 * 128 * 2;
constexpr size_t WS_XB = WS_WL0 + DEPTH * LAYER_BYTES, WS_SSP = WS_XB + (size_t)MP * D * 2, WS_SSV = WS_SSP + (size_t)NPASS * MP * 16 * 4,
                 WS_BIG = WS_SSV + (size_t)MP * 16 * 4, ACT_BYTES = (size_t)MP * D * 2, WS_END = WS_BIG + 4 * ACT_BYTES;
static_assert(WS_END <= (size_t)512 * 1024 * 1024, "workspace budget");
static_assert((size_t)MP * DFF * 2 <= 4 * ACT_BYTES, "H overlays U|V|P|Q");
constexpr int LDS_BYTES = 135168, XB_LDS_OFF = 131072 + 256;

__device__ __forceinline__ unsigned f2bf(float f) { unsigned u = __builtin_bit_cast(unsigned, f); return (u + 0x7fffu + ((u >> 16) & 1u)) >> 16; }
__device__ __forceinline__ unsigned pk2(float lo, float hi) { return pg8::cvt_pk_bf16(lo, hi); }
__device__ __forceinline__ float bflo(unsigned w) { return __builtin_bit_cast(float, w << 16); }
__device__ __forceinline__ float bfhi(unsigned w) { return __builtin_bit_cast(float, w & 0xffff0000u); }
__device__ __forceinline__ float wave_sum(float v) {
#pragma unroll
    for (int o = 1; o < 64; o <<= 1) v += __shfl_xor(v, o);
    return v;
}

__device__ __forceinline__ void tr_item(const float* W, int ldw, int c0, int K, int ncols, const float* gain, bf16* dst, int rmode, int rbase, LAS float* scr, int item, int lane) {
    const int nblk = ncols / 32, kb = item / nblk, nb = item % nblk, k0 = 64 * kb, n0 = 32 * nb;
#pragma unroll
    for (int i = 0; i < 32; ++i) { const int kk = 2 * i + (lane >> 5); const float g = gain ? gain[k0 + kk] : 1.0f; scr[kk * 33 + (lane & 31)] = g * __builtin_nontemporal_load(W + (size_t)(k0 + kk) * ldw + c0 + n0 + (lane & 31)); }
    LDS_WAIT(); asm volatile("" ::: "memory");
    const int c = lane & 7;
#pragma unroll
    for (int j = 0; j < 4; ++j) { const int n = (lane >> 3) + 8 * j; const LAS float* s = scr + (8 * c) * 33 + n;
        v4u o; o.x = pk2(s[0 * 33], s[1 * 33]); o.y = pk2(s[2 * 33], s[3 * 33]); o.z = pk2(s[4 * 33], s[5 * 33]); o.w = pk2(s[6 * 33], s[7 * 33]);
        const int nn = n0 + n; const int drow = rmode ? ((nn >> 7) * 256 + (nn & 127) + rbase) : (nn + rbase);
        *(v4u*)(dst + (size_t)drow * K + k0 + 8 * c) = o; }
    LDS_WAIT(); asm volatile("" ::: "memory");
}
__device__ __forceinline__ void fold_item(const float* win, const float* gmix, bf16* wint, LAS unsigned char* lds, int g, int kb) {
    LAS float* wl = (LAS float*)lds; LAS float* tab = wl + 32 * 256; const int tid = threadIdx.x, k0 = 32 * kb;
    for (int idx = tid; idx < 32 * 256; idx += NTHR) { const int kk = idx >> 8, c = idx & 255; wl[idx] = gmix[k0 + kk] * win[(size_t)(k0 + kk) * 5120 + 2048 + g * 256 + c]; }
    if (tid < 256) tab[tid] = cospif((float)tid * (1.0f / 128.0f)) * 0.0625f;
    __syncthreads();
    const int j = tid & 255, half = tid >> 8;
    float aP[16], aQ[16];
#pragma unroll
    for (int kk = 0; kk < 16; ++kk) { aP[kk] = 0.f; aQ[kk] = 0.f; }
    const LAS f32x4* wl4 = (const LAS f32x4*)wl + (half * 16) * 64;
#pragma unroll 1
    for (int c4 = 0; c4 < 64; ++c4) { float cs[4], sn[4];
#pragma unroll
        for (int e = 0; e < 4; ++e) { const int m = ((4 * c4 + e) * j) & 255; cs[e] = tab[m]; sn[e] = tab[(m + 192) & 255]; }
#pragma unroll
        for (int kk = 0; kk < 16; ++kk) { const f32x4 w = wl4[kk * 64 + c4];
#pragma unroll
            for (int e = 0; e < 4; ++e) { aP[kk] += w[e] * cs[e]; aQ[kk] += w[e] * sn[e]; } } }
    bf16* dP = wint + (size_t)(2048 + g * 256 + j) * 1024 + k0 + half * 16; bf16* dQ = dP + (size_t)1024 * 1024;
    v4u o; o.x = pk2(aP[0], aP[1]); o.y = pk2(aP[2], aP[3]); o.z = pk2(aP[4], aP[5]); o.w = pk2(aP[6], aP[7]); *(v4u*)dP = o;
    o.x = pk2(aP[8], aP[9]); o.y = pk2(aP[10], aP[11]); o.z = pk2(aP[12], aP[13]); o.w = pk2(aP[14], aP[15]); *(v4u*)(dP + 8) = o;
    o.x = pk2(aQ[0], aQ[1]); o.y = pk2(aQ[2], aQ[3]); o.z = pk2(aQ[4], aQ[5]); o.w = pk2(aQ[6], aQ[7]); *(v4u*)dQ = o;
    o.x = pk2(aQ[8], aQ[9]); o.y = pk2(aQ[10], aQ[11]); o.z = pk2(aQ[12], aQ[13]); o.w = pk2(aQ[14], aQ[15]); *(v4u*)(dQ + 8) = o;
    __syncthreads();
}
__device__ __forceinline__ void x0_rows(const float* xin, bf16* xb, float* ssp, int gw, int ngw, int lane) {
    for (int row = gw; row < MP; row += ngw) { const f32x4* xr = (const f32x4*)(xin + (size_t)row * D) + lane; f32x4 v[4]; float s = 0.f;
#pragma unroll
        for (int j = 0; j < 4; ++j) { v[j] = __builtin_nontemporal_load(xr + 64 * j); s += (v[j][0] * v[j][0] + v[j][1] * v[j][1]) + (v[j][2] * v[j][2] + v[j][3] * v[j][3]); }
        s = wave_sum(s);
        v2u* o = (v2u*)(xb + (size_t)row * D) + lane;
#pragma unroll
        for (int j = 0; j < 4; ++j) { v2u w; w.x = pk2(v[j][0], v[j][1]); w.y = pk2(v[j][2], v[j][3]); o[64 * j] = w; }
        if (lane < 16) ssp[(size_t)row * 16 + lane] = lane == 0 ? s : 0.f; }
}
__device__ __forceinline__ void final_rows(float* out, const bf16* xb, const float* ssp, const float* gfin, int gw, int ngw, int lane) {
    for (int row = gw; row < MP; row += ngw) { const f32x4* sp = (const f32x4*)(ssp + (size_t)row * 16); const f32x4 a = sp[0], b = sp[1], c = sp[2], d = sp[3];
        const float ss = ((a[0] + a[1]) + (a[2] + a[3])) + ((b[0] + b[1]) + (b[2] + b[3])) + ((c[0] + c[1]) + (c[2] + c[3])) + ((d[0] + d[1]) + (d[2] + d[3]));
        const float r = 1.0f / sqrtf(ss * (1.0f / D) + EPS);
        f32x4* orow = (f32x4*)(out + (size_t)row * D) + lane; const f32x4* gr = (const f32x4*)gfin + lane; const v2u* xr = (const v2u*)(xb + (size_t)row * D) + lane;
#pragma unroll
        for (int j = 0; j < 4; ++j) { const v2u w = xr[64 * j]; const f32x4 g = gr[64 * j]; const f32x4 v = (f32x4){bflo(w.x), bfhi(w.x), bflo(w.y), bfhi(w.y)}; __builtin_nontemporal_store(v * r * g, orow + 64 * j); } }
}

__device__ __forceinline__ unsigned off_b(unsigned row, unsigned ch) { return 256u * row + 16u * (ch ^ (((row & 3u) << 2) | ((row >> 2) & 3u))); }
template <int MB, int KK, class RP, class XF, class EP>
__device__ __forceinline__ void smm_tile(LAS unsigned char* lds, const bf16* Amat, const RP& rp, const XF& xf, const EP& ep, const int tid_in) {
    const int tid = tid_in, wave = __builtin_amdgcn_readfirstlane(tid >> 6), lane = tid & 63;
    { const int ch = tid & 15, r0 = tid >> 4; v4u v[KK / 32];
#pragma unroll
      for (int i = 0; i < KK / 32; ++i) v[i] = *(const v4u*)(rp(r0 + 32 * i) + ch * 8);
#pragma unroll
      for (int i = 0; i < KK / 32; ++i) { const v4u t = xf(r0 + 32 * i, ch, v[i]); *(LAS v4u*)(lds + off_b(r0 + 32 * i, ch)) = t; } }
    __syncthreads();
    bf16x8 a[MB][KK / 32];
    const bf16* ap = Amat + (size_t)(wave * 16 + (lane & 15)) * KK + (lane >> 4) * 8;
#pragma unroll
    for (int mb = 0; mb < MB; ++mb)
#pragma unroll
        for (int kb = 0; kb < KK / 32; ++kb) a[mb][kb] = *(const bf16x8*)(ap + (size_t)mb * 128 * KK + kb * 32);
    f32x4 acc[MB][8];
#pragma unroll
    for (int mb = 0; mb < MB; ++mb)
#pragma unroll
        for (int nb = 0; nb < 8; ++nb) acc[mb][nb] = (f32x4){0.f, 0.f, 0.f, 0.f};
    const unsigned g = lane >> 4, q = (lane & 15) >> 2, p = lane & 3;
#pragma unroll
    for (int nb = 0; nb < 8; ++nb) {
        bf16x8 b[KK / 32];
#pragma unroll
        for (int kb = 0; kb < KK / 32; ++kb) { const unsigned rA = 32u * kb + 8u * g + q;
            const s16x4 lo = __builtin_amdgcn_ds_read_tr16_b64_v4i16((LAS s16x4*)(lds + off_b(rA, 4 * (nb >> 1) + p) + 8 * (nb & 1)));
            const s16x4 hi = __builtin_amdgcn_ds_read_tr16_b64_v4i16((LAS s16x4*)(lds + off_b(rA + 4, 4 * (nb >> 1) + p) + 8 * (nb & 1)));
            b[kb] = __builtin_shufflevector(lo, hi, 0, 1, 2, 3, 4, 5, 6, 7); }
#pragma unroll
        for (int kb = 0; kb < KK / 32; ++kb)
#pragma unroll
            for (int mb = 0; mb < MB; ++mb) acc[mb][nb] = __builtin_amdgcn_mfma_f32_16x16x32_bf16(b[kb], a[mb][kb], acc[mb][nb], 0, 0, 0); }
    ep(acc, wave, lane);
    __syncthreads();
}
__device__ __forceinline__ void fold_tile(LAS unsigned char* lds, const float* win, const float* gmix, bf16* wint, int g, int kt, int which, const int tid_in) {
    const int tid = tid_in, wave = __builtin_amdgcn_readfirstlane(tid >> 6), lane = tid & 63, k0 = 128 * kt;
    LAS float* tab = (LAS float*)(lds + 65536);
    if (tid < 256) tab[tid] = cospif((float)tid * (1.0f / 128.0f)) * 0.0625f;
    { const int c4 = 4 * lane;
#pragma unroll 4
      for (int i = 0; i < 16; ++i) { const int k = wave + 8 * i; const f32x4 w = *(const f32x4*)(win + (size_t)(k0 + k) * 5120 + 2048 + g * 256 + c4) * gmix[k0 + k];
#pragma unroll
          for (int e = 0; e < 4; ++e) *(LAS unsigned short*)(lds + off_b((unsigned)(c4 + e), (unsigned)(k >> 3)) + (k & 7) * 2) = (unsigned short)f2bf(w[e]); } }
    __syncthreads();
    bf16x8 a[2][8];
    { const int sh = which ? 192 : 0;
#pragma unroll
      for (int mb = 0; mb < 2; ++mb) { const int j = mb * 128 + wave * 16 + (lane & 15);
#pragma unroll
        for (int kb = 0; kb < 8; ++kb) { const int c0 = kb * 32 + (lane >> 4) * 8; unsigned wv[4];
#pragma unroll
            for (int e2 = 0; e2 < 4; ++e2) { const float t0 = tab[(((c0 + 2 * e2) * j) + sh) & 255], t1 = tab[(((c0 + 2 * e2 + 1) * j) + sh) & 255]; wv[e2] = pk2(t0, t1); }
            v4u pv; pv.x = wv[0]; pv.y = wv[1]; pv.z = wv[2]; pv.w = wv[3]; a[mb][kb] = __builtin_bit_cast(bf16x8, pv); } } }
    f32x4 acc[2][8];
#pragma unroll
    for (int mb = 0; mb < 2; ++mb)
#pragma unroll
        for (int nb = 0; nb < 8; ++nb) acc[mb][nb] = (f32x4){0.f, 0.f, 0.f, 0.f};
    const unsigned gq = lane >> 4, q = (lane & 15) >> 2, p = lane & 3;
#pragma unroll
    for (int nb = 0; nb < 8; ++nb) {
        bf16x8 b[8];
#pragma unroll
        for (int kb = 0; kb < 8; ++kb) { const unsigned rA = 32u * kb + 8u * gq + q;
            const s16x4 lo = __builtin_amdgcn_ds_read_tr16_b64_v4i16((LAS s16x4*)(lds + off_b(rA, 4 * (nb >> 1) + p) + 8 * (nb & 1)));
            const s16x4 hi = __builtin_amdgcn_ds_read_tr16_b64_v4i16((LAS s16x4*)(lds + off_b(rA + 4, 4 * (nb >> 1) + p) + 8 * (nb & 1)));
            b[kb] = __builtin_shufflevector(lo, hi, 0, 1, 2, 3, 4, 5, 6, 7); }
#pragma unroll
        for (int kb = 0; kb < 8; ++kb)
#pragma unroll
            for (int mb = 0; mb < 2; ++mb) acc[mb][nb] = __builtin_amdgcn_mfma_f32_16x16x32_bf16(b[kb], a[mb][kb], acc[mb][nb], 0, 0, 0); }
    const int fq = lane >> 4;
#pragma unroll
    for (int mb = 0; mb < 2; ++mb) { const int j = mb * 128 + wave * 16 + (lane & 15); bf16* dst = wint + (size_t)((which ? 3072 : 2048) + g * 256 + j) * 1024 + k0 + fq * 8;
#pragma unroll
        for (int G4 = 0; G4 < 4; ++G4) { const f32x4 y0 = acc[mb][2 * G4], y1 = acc[mb][2 * G4 + 1]; v4u w; w.x = pk2(y0[0], y0[1]); w.y = pk2(y0[2], y0[3]); w.z = pk2(y1[0], y1[1]); w.w = pk2(y1[2], y1[3]); *(v4u*)(dst + G4 * 32) = w; } }
    __syncthreads();
}
struct XfNone { __device__ __forceinline__ v4u operator()(int, int, v4u v) const { return v; } };
struct SguRP { const bf16* base; __device__ __forceinline__ const bf16* operator()(int r) const { return base + (size_t)r * D; } };
struct SguXF { const float* ssv; const float* gv;
    __device__ __forceinline__ v4u operator()(int r, int ch, v4u v) const {
        const f32x4* sp = (const f32x4*)(ssv + (size_t)r * 16); const f32x4 a = sp[0], b = sp[1], c = sp[2], d = sp[3];
        const float ss = ((a[0] + a[1]) + (a[2] + a[3])) + ((b[0] + b[1]) + (b[2] + b[3])) + ((c[0] + c[1]) + (c[2] + c[3])) + ((d[0] + d[1]) + (d[2] + d[3]));
        const float rs = __builtin_amdgcn_rsqf(ss * (1.0f / 1024.0f) + EPS);
        const f32x4 g0 = *(const f32x4*)(gv + ch * 8) * rs, g1 = *(const f32x4*)(gv + ch * 8 + 4) * rs;
        v4u o; o.x = pk2(bflo(v.x) * g0[0], bfhi(v.x) * g0[1]); o.y = pk2(bflo(v.y) * g0[2], bfhi(v.y) * g0[3]);
        o.z = pk2(bflo(v.z) * g1[0], bfhi(v.z) * g1[1]); o.w = pk2(bflo(v.w) * g1[2], bfhi(v.w) * g1[3]); return o; } };
struct SguEP { bf16* ubase; const float* bs;
    __device__ __forceinline__ void operator()(const f32x4 (&acc)[1][8], int wave, int lane) const {
        const int p = wave * 16 + (lane & 15), fq = lane >> 4; const float bias = bs[p];
        v4u uu[4];
#pragma unroll
        for (int G4 = 0; G4 < 4; ++G4) uu[G4] = *(const v4u*)(ubase + (size_t)p * D + G4 * 32 + fq * 8);
#pragma unroll
        for (int G4 = 0; G4 < 4; ++G4) { const f32x4 y0 = acc[0][2 * G4] + bias, y1 = acc[0][2 * G4 + 1] + bias; const v4u u = uu[G4];
            v4u o; o.x = pk2(bflo(u.x) * y0[0], bfhi(u.x) * y0[1]); o.y = pk2(bflo(u.y) * y0[2], bfhi(u.y) * y0[3]);
            o.z = pk2(bflo(u.z) * y1[0], bfhi(u.z) * y1[1]); o.w = pk2(bflo(u.w) * y1[2], bfhi(u.w) * y1[3]);
            *(v4u*)(ubase + (size_t)p * D + G4 * 32 + fq * 8) = o; } } };
struct F1RP { const bf16* pb; const bf16* qb; int n2s; __device__ __forceinline__ const bf16* operator()(int r) const { return ((r >> 7) ? qb : pb) + (size_t)((r & 127) * n2s) * D; } };
struct F1EP { bf16* pb; bf16* qb; int n2s, n2; float invS2;
    __device__ __forceinline__ void operator()(const f32x4 (&acc)[2][8], int wave, int lane) const {
        const int k1 = wave * 16 + (lane & 15), fq = lane >> 4; float sn, cs; sincospif((float)(n2 * k1) * invS2, &sn, &cs);
        bf16* po = pb + (size_t)(k1 * n2s) * D + fq * 8; bf16* qo = qb + (size_t)(k1 * n2s) * D + fq * 8;
#pragma unroll
        for (int G4 = 0; G4 < 4; ++G4) { const f32x4 ar0 = acc[0][2 * G4], ai0 = acc[1][2 * G4], ar1 = acc[0][2 * G4 + 1], ai1 = acc[1][2 * G4 + 1];
            const f32x4 pr0 = ar0 * cs - ai0 * sn, pi0 = ar0 * sn + ai0 * cs, pr1 = ar1 * cs - ai1 * sn, pi1 = ar1 * sn + ai1 * cs;
            v4u o; o.x = pk2(pr0[0], pr0[1]); o.y = pk2(pr0[2], pr0[3]); o.z = pk2(pr1[0], pr1[1]); o.w = pk2(pr1[2], pr1[3]); *(v4u*)(po + G4 * 32) = o;
            o.x = pk2(pi0[0], pi0[1]); o.y = pk2(pi0[2], pi0[3]); o.z = pk2(pi1[0], pi1[1]); o.w = pk2(pi1[2], pi1[3]); *(v4u*)(qo + G4 * 32) = o; } } };
struct F2RP { const bf16* pb; const bf16* qb; __device__ __forceinline__ const bf16* operator()(int r) const { return ((r >> 7) ? qb : pb) + (size_t)(r & 127) * D; } };
struct F2EP { bf16* fb; int blk, sample;
    __device__ __forceinline__ void operator()(const f32x4 (&acc)[1][8], int wave, int lane) const {
        const int o = wave * 16 + (lane & 15), fq = lane >> 4; const int k = sample ? (4 * blk + (o >> 5)) + 128 * (o & 31) : blk + 128 * o;
        bf16* fo = fb + (size_t)k * D + fq * 8;
#pragma unroll
        for (int G4 = 0; G4 < 4; ++G4) { const f32x4 y0 = acc[0][2 * G4], y1 = acc[0][2 * G4 + 1]; v4u w; w.x = pk2(y0[0], y0[1]); w.y = pk2(y0[2], y0[3]); w.z = pk2(y1[0], y1[1]); w.w = pk2(y1[2], y1[3]); *(v4u*)(fo + G4 * 32) = w; } } };

#define XB_TMO      128
#define XB_XCNT(j)  (256  + 64 * (j))
#define XB_XSUB(j)  (1280 + 64 * (j))
#define XB_XGEN(j)  (2304 + 64 * (j))
#define XB_TOP      3328
#define XB_TOPGEN   3392
#define XCD_BAR_WORDS 3456
#define XB_SPIN_CAP (1u << 18)

__device__ __forceinline__ unsigned xb_ld(unsigned* p)              { return __hip_atomic_load(p, __ATOMIC_RELAXED, __HIP_MEMORY_SCOPE_AGENT); }
__device__ __forceinline__ unsigned xb_add(unsigned* p, unsigned v) { return __hip_atomic_fetch_add(p, v, __ATOMIC_RELAXED, __HIP_MEMORY_SCOPE_AGENT); }
__device__ __forceinline__ unsigned xb_xcc_id() { return (unsigned)__builtin_amdgcn_s_getreg((3 << 11) | 20) & 0xFu; }
#define XB_SPIN(cond, bar) do { unsigned _sp = 0; while (cond) { __builtin_amdgcn_s_sleep(1); \
    if ((++_sp & 255u) == 0u) { if (xb_ld(&(bar)[XB_TMO])) break; if (_sp > XB_SPIN_CAP) { atomicAdd(&(bar)[XB_TMO], 1u); break; } } } } while (0)

struct XcdBarrier {
    unsigned* bar; unsigned x;
    volatile LAS unsigned* st;
};

__device__ __forceinline__ XcdBarrier xcd_barrier_post(unsigned* bar, volatile LAS unsigned* st) {
    XcdBarrier b; b.bar = bar; b.x = xb_xcc_id(); b.st = st;
    if (threadIdx.x == 0) (void)xb_add(&bar[XB_XCNT(b.x)], 1u);
    return b;
}
__device__ __forceinline__ void xcd_barrier_complete(unsigned* bar, unsigned x, unsigned& nloc, unsigned& nx) {
    const unsigned G = gridDim.x * gridDim.y * gridDim.z;
    unsigned sum, cnt, mine, sp = 0u;
    for (;;) {
        sum = 0u; cnt = 0u; mine = 0u;
#pragma unroll
        for (unsigned j = 0; j < 16; ++j) { const unsigned c = xb_ld(&bar[XB_XCNT(j)]); sum += c; cnt += (c > 0u) ? 1u : 0u; mine = (j == x) ? c : mine; }
        if (sum == G) break;
        __builtin_amdgcn_s_sleep(1);
        if ((++sp & 255u) == 0u) { if (xb_ld(&bar[XB_TMO])) break; if (sp > XB_SPIN_CAP) { atomicAdd(&bar[XB_TMO], 1u); break; } }
    }
    nloc = mine > 0u ? mine : 1u; nx = cnt > 0u ? cnt : 1u;
}

__device__ __forceinline__ void xcd_barrier(const XcdBarrier& b) {
    asm volatile("s_waitcnt vmcnt(0)" ::: "memory");
    __syncthreads();
    if (threadIdx.x == 0) {
        unsigned* bar = b.bar;
        __builtin_amdgcn_s_waitcnt(0);
        unsigned nloc = b.st[0], nx = b.st[1];
        if (nloc == 0u) { xcd_barrier_complete(bar, b.x, nloc, nx); b.st[0] = nloc; b.st[1] = nx; }
        const unsigned old = xb_add(&bar[XB_XSUB(b.x)], 1u);
        const unsigned gen = old / nloc;
        if (old + 1u == (gen + 1u) * nloc) {
            __builtin_amdgcn_fence(__ATOMIC_RELEASE, "agent");
            asm volatile("s_waitcnt vmcnt(0)" ::: "memory");
            const unsigned og = xb_add(&bar[XB_TOP], 1u);
            const unsigned tg = og / nx;
            if (og + 1u == (tg + 1u) * nx) xb_add(&bar[XB_TOPGEN], 1u);
            else XB_SPIN(xb_ld(&bar[XB_TOPGEN]) == tg, bar);
            __builtin_amdgcn_fence(__ATOMIC_ACQUIRE, "agent");
            xb_add(&bar[XB_XGEN(b.x)], 1u);
            asm volatile("s_waitcnt vmcnt(0)" ::: "memory");
        } else {
            XB_SPIN(xb_ld(&bar[XB_XGEN(b.x)]) == gen, bar);
            __builtin_amdgcn_fence(__ATOMIC_ACQUIRE, "agent");
            asm volatile("s_waitcnt vmcnt(0)" ::: "memory");
        }
    }
    __syncthreads();
}


struct Args { const float* in[19]; float* out; unsigned char* ws; int ph_lo, ph_hi; };
constexpr int STEPS = 10, PASS_PH = DEPTH * STEPS + 1, NPHASE = 1 + NPASS * PASS_PH;

__global__ void __launch_bounds__(NTHR, 2) mk_fwd(Args args) {
    extern __shared__ __attribute__((aligned(16))) unsigned char lds_raw[];
    LAS unsigned char* lds = (LAS unsigned char*)lds_raw;
    typedef const __attribute__((address_space(4))) Args* CArgs;
    { volatile LAS unsigned* st0 = (volatile LAS unsigned*)(lds + XB_LDS_OFF); if (threadIdx.x < 2) st0[threadIdx.x] = 0u; __syncthreads();
      if (args.ph_hi - args.ph_lo > 1) (void)xcd_barrier_post((unsigned*)args.ws, st0); }
    const int ph_lo = args.ph_lo, ph_hi = args.ph_hi;
    for (int ph = ph_lo; ph < ph_hi; ++ph) {
        int tidv = threadIdx.x; asm volatile("" : "+v"(tidv));
        CArgs ap = (CArgs)__builtin_amdgcn_kernarg_segment_ptr(); asm volatile("" : "+s"(ap));
        const int tid = tidv, lane = tid & 63, wave = __builtin_amdgcn_readfirstlane(tid >> 6);
        const int G = gridDim.x, bx = blockIdx.x, gw = bx * NWAVES + wave, ngw = G * NWAVES;
        unsigned char* ws = ap->ws;
        bf16* XB = (bf16*)(ws + WS_XB); float* SSV = (float*)(ws + WS_SSV);
        bf16* Ub = (bf16*)(ws + WS_BIG); bf16* Vb = Ub + (size_t)MP * D; bf16* Pb = Vb + (size_t)MP * D; bf16* Qb = Pb + (size_t)MP * D; bf16* Hb = Ub;
        bf16* GAb = (bf16*)(ap->out + (size_t)MP * D); bf16* GBb = GAb + (size_t)MP * D;
        const bf16* F1 = (const bf16*)(ws + WS_F1); const bf16* F2P = (const bf16*)(ws + WS_F2P); const bf16* F2S = (const bf16*)(ws + WS_F2S);
        if (ph == 0) {
            LAS float* scr = (LAS float*)(lds + wave * 16384);
            int it = gw;
#define TRJOB(W, ldw, c0, K, ncols, gain, dst, rmode, rbase) { const int n_ = ((K) / 64) * ((ncols) / 32); for (; it < n_; it += ngw) tr_item(W, ldw, c0, K, ncols, gain, dst, rmode, rbase, scr, it, lane); it -= n_; }
            for (int l = 0; l < DEPTH; ++l) { unsigned char* wl = ws + WS_WL0 + (size_t)l * LAYER_BYTES;
                TRJOB(ap->in[3] + (size_t)l * D * DFF, DFF, 0, D, DFF, ap->in[2] + l * D, (bf16*)(wl + L_WGU1), 1, 0)
                TRJOB(ap->in[4] + (size_t)l * D * DFF, DFF, 0, D, DFF, ap->in[2] + l * D, (bf16*)(wl + L_WGU1), 1, 128)
                TRJOB(ap->in[5] + (size_t)l * DFF * D, D, 0, DFF, D, (const float*)nullptr, (bf16*)(wl + L_WD1), 0, 0)
                TRJOB(ap->in[7] + (size_t)l * D * 5120, 5120, 0, D, 2048, ap->in[6] + l * D, (bf16*)(wl + L_WIN), 0, 0)
                TRJOB(ap->in[7] + (size_t)l * D * 5120, 5120, 3072, D, 2048, ap->in[6] + l * D, (bf16*)(wl + L_WIN), 0, 4096)
                TRJOB(ap->in[11] + (size_t)l * D * D, D, 0, D, D, (const float*)nullptr, (bf16*)(wl + L_WA), 0, 0)
                TRJOB(ap->in[12] + (size_t)l * D * D, D, 0, D, D, (const float*)nullptr, (bf16*)(wl + L_WB), 0, 0)
                TRJOB(ap->in[13] + (size_t)l * D * D, D, 0, D, D, (const float*)nullptr, (bf16*)(wl + L_WO), 0, 0)
                TRJOB(ap->in[15] + (size_t)l * D * DFF, DFF, 0, D, DFF, ap->in[14] + l * D, (bf16*)(wl + L_WGU2), 1, 0)
                TRJOB(ap->in[16] + (size_t)l * D * DFF, DFF, 0, D, DFF, ap->in[14] + l * D, (bf16*)(wl + L_WGU2), 1, 128)
                TRJOB(ap->in[17] + (size_t)l * DFF * D, D, 0, DFF, D, (const float*)nullptr, (bf16*)(wl + L_WD2), 0, 0)
            }
#undef TRJOB
            __syncthreads();
            for (int item = bx; item < DEPTH * 64; item += G) { const int l = item >> 6, g = (item >> 4) & 3, kt = (item >> 1) & 7, which = item & 1;
                fold_tile(lds, ap->in[7] + (size_t)l * D * 5120, ap->in[6] + l * D, (bf16*)(ws + WS_WL0 + (size_t)l * LAYER_BYTES + L_WIN), g, kt, which, tidv); }
            { const int gt = bx * NTHR + tid, ngt = G * NTHR;
              for (int i = gt; i < DEPTH * 8 * 128 * 128; i += ngt) { const int l = i >> 17, r = i & 131071; ((bf16*)(ws + WS_WL0 + (size_t)l * LAYER_BYTES + L_WS))[r] = (bf16)f2bf(ap->in[9][i]); }
              for (int i = gt; i < 256 * 256; i += ngt) { const int r = i >> 8, c = i & 255, m = ((r & 127) * (c & 127)) & 127; float sn, cs; sincospif((float)m * (1.0f / 64.0f), &sn, &cs);
                  const float sc = 0.08838834764831845f; float v = (r < 128) ? ((c < 128) ? cs : -sn) : ((c < 128) ? sn : cs); ((bf16*)(ws + WS_F1))[i] = (bf16)f2bf(v * sc); }
              for (int i = gt; i < 128 * 256; i += ngt) { const int r = i >> 8, c = i & 255, m = (r * (c & 127)) & 127; float sn, cs; sincospif((float)m * (1.0f / 64.0f), &sn, &cs);
                  ((bf16*)(ws + WS_F2P))[i] = (bf16)f2bf(((c < 128) ? cs : -sn) * 0.08838834764831845f); }
              for (int i = gt; i < 128 * 256; i += ngt) { const int o = i >> 8, c = i & 255, ii = c & 127, m = ((o & 31) * (ii & 31)) & 31; float sn, cs; sincospif((float)m * (1.0f / 16.0f), &sn, &cs);
                  const float v = ((o >> 5) == (ii >> 5)) ? ((c < 128) ? cs : -sn) * 0.17677669529663687f : 0.f; ((bf16*)(ws + WS_F2S))[i] = (bf16)f2bf(v); } }
            x0_rows(ap->in[0], XB, (float*)(ws + WS_SSP), gw, ngw, lane);
        } else {
            const int q = ph - 1, pass = q / PASS_PH, s = q % PASS_PH;
            float* SSP = (float*)(ws + WS_SSP) + (size_t)pass * MP * 16;
            float* X = ap->out + (size_t)pass * MP * D;
            if (s == PASS_PH - 1) {
                final_rows(X, XB, SSP, ap->in[18], gw, ngw, lane);
                if (pass + 1 < NPASS) x0_rows(ap->in[pass + 1], XB, (float*)(ws + WS_SSP) + (size_t)(pass + 1) * MP * 16, gw, ngw, lane);
            } else {
                const int l = s / STEPS, step = s % STEPS;
                unsigned char* wl = ws + WS_WL0 + (size_t)l * LAYER_BYTES;
                const int S = pass == 0 ? 16384 : 4096, N2 = S / 128;
                switch (step) {
                case 0: case 8: {
                    pg8::Gemm g{XB, (const bf16*)(wl + (step == 0 ? L_WGU1 : L_WGU2)), MP, 2 * DFF, D}; pg8::StaticOrder so; so.init(MP, 2 * DFF, G, bx);
                    pg8::EpiSwiGLU E{Hb, SSP, DFF};
                    pg8::gemm_phase<pg8::EpiSwiGLU, pg8::StaticOrder, true, true>(lds, g, so, E, tidv);
                } break;
                case 1: case 9: {
                    pg8::Gemm g{Hb, (const bf16*)(wl + (step == 1 ? L_WD1 : L_WD2)), MP, D, DFF}; pg8::StaticOrder so; so.init(MP, D, G, bx);
                    pg8::EpiResid E{XB, SSP, 0.5f};
                    pg8::gemm_phase<pg8::EpiResid, pg8::StaticOrder, true, true>(lds, g, so, E, tidv);
                } break;
                case 2: {
                    pg8::Gemm g{XB, (const bf16*)(wl + L_WIN), MP, 6144, D}; pg8::StaticOrder so; so.init(MP, 6144, G, bx);
                    pg8::EpiW1 E{Ub, GAb, (size_t)MP * D, SSP, SSV};
                    pg8::gemm_phase<pg8::EpiW1, pg8::StaticOrder, true, true>(lds, g, so, E, tidv);
                } break;
                case 3: {
                    for (int t = bx; t < 4096; t += G) {
                        if (t < 2048) { const int ct = t & 7, rest = t >> 3, n2 = rest % N2, sq = rest / N2; const size_t o = ((size_t)sq * S + n2) * D + ct * 128;
                            F1RP rp{Pb + o, Qb + o, N2}; F1EP ep{Pb + o, Qb + o, N2, n2, 2.0f / (float)S};
                            smm_tile<2, 256>(lds, F1, rp, XfNone{}, ep, tidv);
                        } else { const int tt = t - 2048, h = tt & 7, c = tt >> 3; const size_t o = (size_t)c * 128 * D + h * 128;
                            SguRP rp{Vb + o}; SguXF xf{SSV + (size_t)c * 128 * 16, ap->in[8] + l * D + h * 128}; SguEP ep{Ub + o, ap->in[10] + (l * 8 + h) * 128};
                            smm_tile<1, 128>(lds, (const bf16*)(wl + L_WS) + (size_t)h * 128 * 128, rp, xf, ep, tidv); } }
                } break;
                case 4: {
                    const int nblk = S / 128;
                    for (int t = bx; t < 2048; t += G) { const int ct = t & 7, rest = t >> 3, blk = rest % nblk, sq = rest / nblk; const size_t o = ((size_t)sq * S + (size_t)blk * 128) * D + ct * 128;
                        F2RP rp{Pb + o, Qb + o}; F2EP ep{Vb + (size_t)sq * S * D + ct * 128, blk, pass};
                        smm_tile<1, 256>(lds, pass ? F2S : F2P, rp, XfNone{}, ep, tidv); }
                } break;
                case 5: {
                    pg8::Gemm g{Ub, (const bf16*)(wl + L_WA), MP, D, D}; pg8::StaticOrder so; so.init(MP, D, G, bx);
                    pg8::EpiMerge<0> E{GAb, GBb};
                    pg8::gemm_phase<pg8::EpiMerge<0>, pg8::StaticOrder, true, true>(lds, g, so, E, tidv);
                } break;
                case 6: {
                    pg8::Gemm g{Vb, (const bf16*)(wl + L_WB), MP, D, D}; pg8::StaticOrder so; so.init(MP, D, G, bx);
                    pg8::EpiMerge<1> E{GAb, GBb};
                    pg8::gemm_phase<pg8::EpiMerge<1>, pg8::StaticOrder, true, true>(lds, g, so, E, tidv);
                } break;
                case 7: {
                    pg8::Gemm g{GAb, (const bf16*)(wl + L_WO), MP, D, D}; pg8::StaticOrder so; so.init(MP, D, G, bx);
                    pg8::EpiResid E{XB, SSP, 1.0f};
                    pg8::gemm_phase<pg8::EpiResid, pg8::StaticOrder, true, true>(lds, g, so, E, tidv);
                } break;
                }
            }
        }
        if (ph + 1 < ph_hi) {
            if (ph_hi > 1000000) { __syncthreads(); cg::this_grid().sync(); }
            else if (ph > 0 && ((ph - 1) % PASS_PH) != PASS_PH - 1 && (((ph - 1) % PASS_PH) % STEPS) == 4) { __syncthreads(); }
            else { XcdBarrier xb; xb.bar = (unsigned*)ws; xb.x = xb_xcc_id(); xb.st = (volatile LAS unsigned*)(lds + XB_LDS_OFF); xcd_barrier(xb); }
        }
    }
}

extern "C" void kernel_launch(void* const* d_in, const int* in_sizes, int n_in, void* d_out, int out_size, void* d_ws, size_t ws_size, hipStream_t stream) {
    static int grid = 0;
    if (grid == 0) {
        if (n_in != 19 || out_size != NPASS * MP * D || ws_size < WS_END) { fprintf(stderr, "kernel_launch: unexpected shapes (n_in %d, out %d, ws %zu < %zu)\n", n_in, out_size, ws_size, (size_t)WS_END); grid = -1; return; }
        int dev = 0, cus = 0, per_cu = 0;
        hipGetDevice(&dev); hipDeviceGetAttribute(&cus, hipDeviceAttributeMultiprocessorCount, dev);
        if (hipFuncSetAttribute((const void*)mk_fwd, hipFuncAttributeMaxDynamicSharedMemorySize, LDS_BYTES) != hipSuccess) { fprintf(stderr, "kernel_launch: hipFuncSetAttribute failed\n"); grid = -1; return; }
        if (hipOccupancyMaxActiveBlocksPerMultiprocessor(&per_cu, (const void*)mk_fwd, NTHR, LDS_BYTES) != hipSuccess || per_cu < 1) { fprintf(stderr, "kernel_launch: occupancy query says %d\n", per_cu); per_cu = 1; }
        (void)hipGetLastError();
        grid = cus * 1;
    }
    if (grid < 0) return;
    if (hipMemsetAsync(d_ws, 0, 16384, stream) != hipSuccess) { fprintf(stderr, "kernel_launch: memset of the barrier words failed\n"); return; }
    Args a{};
    for (int i = 0; i < 19; ++i) a.in[i] = (const float*)d_in[i];
    a.out = (float*)d_out; a.ws = (unsigned char*)d_ws;
#if MK_PER_PHASE
    for (int ph = 0; ph < NPHASE; ++ph) { a.ph_lo = ph; a.ph_hi = ph + 1; hipLaunchKernelGGL(mk_fwd, dim3(grid), dim3(NTHR), LDS_BYTES, stream, a); }
#else
    a.ph_lo = 0; a.ph_hi = NPHASE;
    void* kargs[] = {&a};
    hipError_t e = hipLaunchCooperativeKernel((const void*)mk_fwd, dim3(grid), dim3(NTHR), kargs, LDS_BYTES, stream);
    if (e != hipSuccess) fprintf(stderr, "kernel_launch: cooperative launch failed: %s (grid %d)\n", hipGetErrorString(e), grid);
#endif
}
```
